# Optimizing an MI355X kernel written in HIP

```python
import jax, jax.numpy as jnp
from jax import lax
import numpy as np

D_MODEL = 2048
BATCH = 1
SEQ = 8192
DEPTH = 1

CHUNK = 128
A_HEADS = 8
A_HEAD_DIM = D_MODEL // A_HEADS
A_WIDTH = A_HEADS * A_HEAD_DIM
POOL_WINDOWS = (2, 4, 8, 16)
B_GROUPS = len(POOL_WINDOWS)
B_GROUP_DIM = D_MODEL // 8
B_WIDTH = B_GROUPS * B_GROUP_DIM
IN_COLS = 2 * A_WIDTH + B_WIDTH + 2 * D_MODEL
FFN_DIM = 5632
CONV_WIDTH = 3
N_MOD = 6
EPS = 1e-6

kernel_name = "hybrid_sgu_pool_convffn_block"


def rms_norm(x, g):
    xf = x.astype(jnp.float32)
    y = xf * lax.rsqrt(jnp.mean(xf * xf, axis=-1, keepdims=True) + EPS)
    return (y * g.astype(jnp.float32)).astype(x.dtype)


def layer_norm(x, g, b):
    xf = x.astype(jnp.float32)
    mu = jnp.mean(xf, axis=-1, keepdims=True)
    xc = xf - mu
    y = xc * lax.rsqrt(jnp.mean(xc * xc, axis=-1, keepdims=True) + EPS)
    return (y * g.astype(jnp.float32) + b.astype(jnp.float32)).astype(x.dtype)


def spatial_gating(u, v, ln_g, ln_b, w_s, b_s):
    B, S, _ = v.shape
    n_chunks = S // CHUNK
    vn = layer_norm(v, ln_g, ln_b).reshape(B, n_chunks, CHUNK, A_HEADS, A_HEAD_DIM)
    mask = jnp.tril(jnp.ones((CHUNK, CHUNK), dtype=bool))
    w = jnp.where(mask[None], w_s, jnp.zeros_like(w_s)).astype(vn.dtype)
    mixed = jnp.einsum('hij,bnjhd->bnihd', w, vn) + b_s.T[None, None, :, :, None]
    return u * mixed.reshape(B, S, A_WIDTH)


def multiscale_pool(p, w_pool, pool_scale):
    B, S, _ = p.shape
    groups = p.reshape(B, S, B_GROUPS, B_GROUP_DIM)
    pos = jnp.arange(1, S + 1, dtype=jnp.float32)[None, :, None]
    outs = []
    for gi, win in enumerate(POOL_WINDOWS):
        pg = groups[:, :, gi].astype(jnp.float32)
        cs = jnp.cumsum(pg, axis=1)
        lagged = jnp.pad(cs, ((0, 0), (win, 0), (0, 0)))[:, :S]
        mean = (cs - lagged) / jnp.minimum(pos, float(win))
        pooled = (mean - pg).astype(p.dtype)
        outs.append(jnp.einsum('bsc,ce->bse', pooled, w_pool[gi]))
    return jnp.concatenate(outs, axis=-1) * pool_scale


def causal_depthwise_conv(h, w, b):
    S = h.shape[1]
    hp = jnp.pad(h, ((0, 0), (CONV_WIDTH - 1, 0), (0, 0)))
    out = b
    for k in range(CONV_WIDTH):
        out = out + hp[:, k:k + S] * w[k]
    return out


def hybrid_layer(x, c, w_ada, b_ada, g_pre_mix, g_post_mix, w_in, ln_v_g, ln_v_b,
                 w_spatial, b_spatial, w_pool, pool_scale, w_branch_a, w_branch_b,
                 w_out, g_pre_ffn, g_post_ffn, w_up, conv_w, conv_b, w_down):
    mod = jax.nn.silu(c) @ w_ada + b_ada
    shift_m, scale_m, gate_m, shift_f, scale_f, gate_f = [
        m[:, None, :] for m in jnp.split(mod, N_MOD, axis=-1)]

    h = rms_norm(x, g_pre_mix) * (1.0 + scale_m) + shift_m
    proj = h @ w_in
    u, v, p, ga, gb = jnp.split(
        proj, [A_WIDTH, 2 * A_WIDTH, 2 * A_WIDTH + B_WIDTH, 2 * A_WIDTH + B_WIDTH + D_MODEL], axis=-1)
    u = jax.nn.gelu(u)
    v = jax.nn.gelu(v)
    y_a = spatial_gating(u, v, ln_v_g, ln_v_b, w_spatial, b_spatial) @ w_branch_a
    y_b = multiscale_pool(p, w_pool, pool_scale) @ w_branch_b
    merged = jax.nn.sigmoid(ga) * y_a + jax.nn.sigmoid(gb) * y_b
    mix = merged @ w_out
    x = x + gate_m * rms_norm(mix, g_post_mix)

    h = rms_norm(x, g_pre_ffn) * (1.0 + scale_f) + shift_f
    up = causal_depthwise_conv(h @ w_up, conv_w, conv_b)
    a, g = jnp.split(up, 2, axis=-1)
    y = (jax.nn.gelu(a) * g) @ w_down
    x = x + gate_f * rms_norm(y, g_post_ffn)
    return x


def setup_inputs(seed: int = 0) -> dict:
    key = jax.random.key(seed)
    ks = jax.random.split(key, 24)
    f32 = jnp.float32
    L, D = DEPTH, D_MODEL

    def nrm(k, shape, scale):
        return jax.random.normal(k, shape, f32) * scale

    def gain(k, shape):
        return 1.0 + 0.02 * jax.random.normal(k, shape, f32)

    return {
        "x": jax.random.normal(ks[0], (BATCH, SEQ, D), f32),
        "c": jax.random.normal(ks[1], (BATCH, D), f32),
        "w_ada": nrm(ks[2], (L, D, N_MOD * D), 0.5 * D ** -0.5),
        "b_ada": nrm(ks[3], (L, N_MOD * D), 0.01),
        "g_pre_mix": gain(ks[4], (L, D)),
        "g_post_mix": gain(ks[5], (L, D)),
        "w_in": nrm(ks[6], (L, D, IN_COLS), D ** -0.5),
        "ln_v_g": gain(ks[7], (L, A_WIDTH)),
        "ln_v_b": nrm(ks[8], (L, A_WIDTH), 0.01),
        "w_spatial": nrm(ks[9], (L, A_HEADS, CHUNK, CHUNK), CHUNK ** -0.5),
        "b_spatial": gain(ks[10], (L, A_HEADS, CHUNK)),
        "w_pool": nrm(ks[11], (L, B_GROUPS, B_GROUP_DIM, B_GROUP_DIM), B_GROUP_DIM ** -0.5),
        "pool_scale": gain(ks[12], (L, B_WIDTH)),
        "w_branch_a": nrm(ks[13], (L, A_WIDTH, D), A_WIDTH ** -0.5),
        "w_branch_b": nrm(ks[14], (L, B_WIDTH, D), B_WIDTH ** -0.5),
        "w_out": nrm(ks[15], (L, D, D), D ** -0.5),
        "g_pre_ffn": gain(ks[16], (L, D)),
        "g_post_ffn": gain(ks[17], (L, D)),
        "w_up": nrm(ks[18], (L, D, 2 * FFN_DIM), D ** -0.5),
        "conv_w": nrm(ks[19], (L, CONV_WIDTH, 2 * FFN_DIM), CONV_WIDTH ** -0.5),
        "conv_b": nrm(ks[20], (L, 2 * FFN_DIM), 0.01),
        "w_down": nrm(ks[21], (L, FFN_DIM, D), FFN_DIM ** -0.5),
    }


def reference(x, c, w_ada, b_ada, g_pre_mix, g_post_mix, w_in, ln_v_g, ln_v_b,
              w_spatial, b_spatial, w_pool, pool_scale, w_branch_a, w_branch_b,
              w_out, g_pre_ffn, g_post_ffn, w_up, conv_w, conv_b, w_down):
    for l in range(DEPTH):
        x = hybrid_layer(x, c, w_ada[l], b_ada[l], g_pre_mix[l], g_post_mix[l], w_in[l],
                         ln_v_g[l], ln_v_b[l], w_spatial[l], b_spatial[l], w_pool[l],
                         pool_scale[l], w_branch_a[l], w_branch_b[l], w_out[l],
                         g_pre_ffn[l], g_post_ffn[l], w_up[l], conv_w[l], conv_b[l], w_down[l])
    return x
```

```cpp
#include <hip/hip_runtime.h>
#include <cstdio>
#include <cstdint>
namespace pg8 {
#define PG8_LAS __attribute__((address_space(3)))
typedef unsigned short bf16_t;
typedef short bf16x8 __attribute__((ext_vector_type(8)));
typedef float f32x4 __attribute__((ext_vector_type(4)));
typedef unsigned u32x4 __attribute__((ext_vector_type(4)));
constexpr int BM = 256, BK = 64, HALF = 128, HTB = HALF * BK * 2  , STAGE_BYTES = 8 * HTB, NXCD = 8, WGM = 8;

__host__ __device__ __forceinline__ int lds_byte(int r, int c) { const int st = (r >> 4) * 2 + (c >> 5), rr = r & 15, cc = c & 31, ob = rr * 64 + cc * 2; return st * 1024 + (ob ^ (((ob >> 9) & 1) << 5)); }
__host__ __device__ __forceinline__ void stage_rc(int b, int& R, int& C) { const int st = b / 1024, sb = b % 1024, swz = sb ^ (((sb >> 9) & 1) << 5); R = (st >> 1) * 16 + swz / 64; C = (st & 1) * 32 + (swz % 64) / 2; }
__host__ __device__ __forceinline__ int perm32(int rho) { const int n = rho >> 4, i = rho & 15; return 8 * (i >> 2) + 4 * n + (i & 3); }

struct Unit { int pm, pn; };
struct Gemm { const bf16_t* A; const bf16_t* Bt; int M, N, K; };

struct StaticOrder {
    int nM, nN, nwg, G, c;
    __host__ __device__ void init(int M, int N, int G_, int c_) { nM = M / BM; nN = N / BM; nwg = nM * nN; G = G_; c = c_; }
    __host__ __device__ bool next(int i, Unit& u) const {
        const long L = (long)i * G + c; if (L >= nwg) return false;
        int wgid = (int)L; { const int q = nwg / NXCD, r = nwg % NXCD, xcd = wgid % NXCD, off = wgid / NXCD; wgid = (xcd < r ? xcd * (q + 1) : r * (q + 1) + (xcd - r) * q) + off; }
        const int nig = WGM * nN, gid = wgid / nig, fm = gid * WGM, gsz = (nM - fm) < WGM ? (nM - fm) : WGM;
        u.pm = fm + ((wgid % nig) % gsz); u.pn = (wgid % nig) / gsz; return true;
    }
    __device__ __forceinline__ void a_ready(const Unit&) const {}
    __device__ __forceinline__ void done(const Unit&) const {}
};

__device__ __forceinline__ unsigned cvt_pk_bf16(float lo, float hi) { unsigned r; asm volatile("v_cvt_pk_bf16_f32 %0, %1, %2" : "=v"(r) : "v"(lo), "v"(hi)); return r; }
__device__ __forceinline__ float bf_lo(unsigned w) { return __builtin_bit_cast(float, w << 16); }
__device__ __forceinline__ float bf_hi(unsigned w) { return __builtin_bit_cast(float, w & 0xffff0000u); }
__device__ __forceinline__ float sigmoid_f(float z) { return __builtin_amdgcn_rcpf(1.0f + __builtin_amdgcn_exp2f(z * -1.44269504089f)); }
__device__ __forceinline__ float gelu_tanh_f(float x) { const float z = x * (1.5957691216f + 0.0713548163f * x * x); return x * sigmoid_f(z); }

struct EpiIn {
    static constexpr bool PERM = true, AFTER_DRAIN = false; static constexpr int MIDK = 0;
    bf16_t *U, *V, *P, *GA, *GB; float* stats;
    __device__ __forceinline__ void mid(f32x4 (&)[2][2][4][2], const Unit&, int, int, int, int) const {}
    __device__ __forceinline__ void operator()(const f32x4 (&acc)[2][2][4][2], const Unit& u, int wr, int wc, int fr, int fq) const {
        const int pn = u.pn; bf16_t* base; int ldc, colt, act;
        if (pn < 8) { base = U; ldc = 2048; colt = pn * BM; act = 1; }
        else if (pn < 16) { base = V; ldc = 2048; colt = (pn - 8) * BM; act = 3; }
        else if (pn < 20) { base = P; ldc = 1024; colt = (pn - 16) * BM; act = 0; }
        else if (pn < 28) { base = GA; ldc = 2048; colt = (pn - 20) * BM; act = 2; }
        else { base = GB; ldc = 2048; colt = (pn - 28) * BM; act = 2; }
        const int row0 = u.pm * BM + wr * 64 + fr, col0 = colt + wc * 32 + 8 * fq;
#pragma unroll
        for (int ai = 0; ai < 2; ++ai)
#pragma unroll
            for (int m = 0; m < 4; ++m) { const int row = row0 + ai * HALF + m * 16; bf16_t* rowp = base + (size_t)row * ldc + col0; float s = 0.f, q = 0.f;
#pragma unroll
                for (int bj = 0; bj < 2; ++bj) { f32x4 v0 = acc[ai][bj][m][0], v1 = acc[ai][bj][m][1];
                    if (act == 1 || act == 3) {
#pragma unroll
                        for (int j = 0; j < 4; ++j) { v0[j] = gelu_tanh_f(v0[j]); v1[j] = gelu_tanh_f(v1[j]); } }
                    else if (act == 2) {
#pragma unroll
                        for (int j = 0; j < 4; ++j) { v0[j] = sigmoid_f(v0[j]); v1[j] = sigmoid_f(v1[j]); } }
                    if (act == 3) {
#pragma unroll
                        for (int j = 0; j < 4; ++j) { s += v0[j] + v1[j]; q += v0[j] * v0[j] + v1[j] * v1[j]; } }
                    u32x4 w; w.x = cvt_pk_bf16(v0[0], v0[1]); w.y = cvt_pk_bf16(v0[2], v0[3]); w.z = cvt_pk_bf16(v1[0], v1[1]); w.w = cvt_pk_bf16(v1[2], v1[3]);
                    *(u32x4*)(rowp + bj * HALF) = w; }
                if (act == 3) { s += __shfl_xor(s, 16); s += __shfl_xor(s, 32); q += __shfl_xor(q, 16); q += __shfl_xor(q, 32);
                    if (fq == 0) { atomicAdd(stats + 2 * row, s); atomicAdd(stats + 2 * row + 1, q); } } }
    }
};
struct EpiBf16Plain {
    static constexpr bool PERM = true, AFTER_DRAIN = false; static constexpr int MIDK = 0;
    bf16_t* O; int ldc;
    __device__ __forceinline__ void mid(f32x4 (&)[2][2][4][2], const Unit&, int, int, int, int) const {}
    __device__ __forceinline__ void operator()(const f32x4 (&acc)[2][2][4][2], const Unit& u, int wr, int wc, int fr, int fq) const {
        const int row0 = u.pm * BM + wr * 64 + fr, col0 = u.pn * BM + wc * 32 + 8 * fq;
#pragma unroll
        for (int ai = 0; ai < 2; ++ai)
#pragma unroll
            for (int m = 0; m < 4; ++m) { bf16_t* rowp = O + (size_t)(row0 + ai * HALF + m * 16) * ldc + col0;
#pragma unroll
                for (int bj = 0; bj < 2; ++bj) { const f32x4 v0 = acc[ai][bj][m][0], v1 = acc[ai][bj][m][1];
                    u32x4 w; w.x = cvt_pk_bf16(v0[0], v0[1]); w.y = cvt_pk_bf16(v0[2], v0[3]); w.z = cvt_pk_bf16(v1[0], v1[1]); w.w = cvt_pk_bf16(v1[2], v1[3]);
                    *(u32x4*)(rowp + bj * HALF) = w; } }
    }
};
struct EpiMerge {
    static constexpr bool PERM = true, AFTER_DRAIN = false; static constexpr int MIDK = 32;
    const bf16_t *GA, *GB; bf16_t* O;
    __device__ __forceinline__ void mid(f32x4 (&acc)[2][2][4][2], const Unit& u, int wr, int wc, int fr, int fq) const {
        int row0 = u.pm * BM + wr * 64 + fr; const int col0 = u.pn * BM + wc * 32 + 8 * fq;
        asm volatile("" : "+v"(row0));
#pragma unroll
        for (int ai = 0; ai < 2; ++ai)
#pragma unroll
            for (int m = 0; m < 4; ++m) { const size_t off = (size_t)(row0 + ai * HALF + m * 16) * 2048 + col0;
#pragma unroll
                for (int bj = 0; bj < 2; ++bj) { const u32x4 a = *(const u32x4*)(GA + off + bj * HALF), b = *(const u32x4*)(GB + off + bj * HALF);
                    f32x4 r0, r1;
                    r0[0] = bf_lo(a.x) * __builtin_amdgcn_rcpf(bf_lo(b.x)); r0[1] = bf_hi(a.x) * __builtin_amdgcn_rcpf(bf_hi(b.x));
                    r0[2] = bf_lo(a.y) * __builtin_amdgcn_rcpf(bf_lo(b.y)); r0[3] = bf_hi(a.y) * __builtin_amdgcn_rcpf(bf_hi(b.y));
                    r1[0] = bf_lo(a.z) * __builtin_amdgcn_rcpf(bf_lo(b.z)); r1[1] = bf_hi(a.z) * __builtin_amdgcn_rcpf(bf_hi(b.z));
                    r1[2] = bf_lo(a.w) * __builtin_amdgcn_rcpf(bf_lo(b.w)); r1[3] = bf_hi(a.w) * __builtin_amdgcn_rcpf(bf_hi(b.w));
                    acc[ai][bj][m][0] *= r0; acc[ai][bj][m][1] *= r1; }
                asm volatile("" ::: "memory"); }
    }
    __device__ __forceinline__ void operator()(const f32x4 (&acc)[2][2][4][2], const Unit& u, int wr, int wc, int fr, int fq) const {
        int row0 = u.pm * BM + wr * 64 + fr; const int col0 = u.pn * BM + wc * 32 + 8 * fq;
        asm volatile("" : "+v"(row0));
#pragma unroll
        for (int ai = 0; ai < 2; ++ai)
#pragma unroll
            for (int m = 0; m < 4; ++m) { const size_t off = (size_t)(row0 + ai * HALF + m * 16) * 2048 + col0;
#pragma unroll
                for (int bj = 0; bj < 2; ++bj) { const u32x4 b = *(const u32x4*)(GB + off + bj * HALF); const f32x4 v0 = acc[ai][bj][m][0], v1 = acc[ai][bj][m][1];
                    u32x4 w; w.x = cvt_pk_bf16(v0[0] * bf_lo(b.x), v0[1] * bf_hi(b.x)); w.y = cvt_pk_bf16(v0[2] * bf_lo(b.y), v0[3] * bf_hi(b.y));
                    w.z = cvt_pk_bf16(v1[0] * bf_lo(b.z), v1[1] * bf_hi(b.z)); w.w = cvt_pk_bf16(v1[2] * bf_lo(b.w), v1[3] * bf_hi(b.w));
                    *(u32x4*)(O + off + bj * HALF) = w; }
                asm volatile("" ::: "memory"); }
    }
};
struct EpiF32 {
    static constexpr bool PERM = false, AFTER_DRAIN = false; static constexpr int MIDK = 0;
    float* C; int ldc;
    __device__ __forceinline__ void mid(f32x4 (&)[2][2][4][2], const Unit&, int, int, int, int) const {}
    __device__ __forceinline__ void operator()(const f32x4 (&acc)[2][2][4][2], const Unit& u, int wr, int wc, int fr, int fq) const {
        const int row0 = u.pm * BM + wr * 64 + fr, col0 = u.pn * BM + wc * 32 + 4 * fq;
#pragma unroll
        for (int ai = 0; ai < 2; ++ai)
#pragma unroll
            for (int m = 0; m < 4; ++m) { float* rowp = C + (size_t)(row0 + ai * HALF + m * 16) * ldc + col0;
#pragma unroll
                for (int bj = 0; bj < 2; ++bj)
#pragma unroll
                    for (int n = 0; n < 2; ++n) *(f32x4*)(rowp + bj * HALF + n * 16) = acc[ai][bj][m][n]; }
    }
};

template <class Epi, class Sched, bool ALIGN_EPI = false, bool SP2 = false>
__device__ __forceinline__ void gemm_phase(PG8_LAS unsigned char* lds, const Gemm g, const Sched& S, const Epi& E) {
    const int tid = threadIdx.x, wid = __builtin_amdgcn_readfirstlane(tid >> 6), lane = tid & 63, wr = wid >> 2, wc = wid & 3, fr = lane & 15, fq = lane >> 4;
    const int K = g.K, nt = K / BK;
    unsigned voffA[2], voffB[2];
#pragma unroll
    for (int i = 0; i < 2; ++i) { int R, C; stage_rc(tid * 16 + i * 8192, R, C); const int Rb = Epi::PERM ? ((R & ~31) + perm32(R & 31)) : R;
        voffA[i] = (unsigned)(R * K + C) * 2u; voffB[i] = (unsigned)(Rb * K + C) * 2u; }
    const size_t kstep = (size_t)(BK * 2);
    const size_t hstep = (size_t)HALF * K * 2;
    const size_t tstep = 2 * hstep;
    const unsigned ldsw = (unsigned)wid * 1024u;
    const int aoff = lds_byte(wr * 64 + fr, fq * 8), boff = lds_byte(wc * 32 + fr, fq * 8);
#define PG8_SA(b, h) (((b) * 2 + (h)) * HTB)
#define PG8_SB(b, h) ((4 + (b) * 2 + (h)) * HTB)
#define PG8_STAGE(bufoff, gbase, voff) do { _Pragma("unroll") for (int _i = 0; _i < 2; ++_i) \
        __builtin_amdgcn_global_load_lds((const unsigned*)((const char*)(gbase) + (voff)[_i]), (PG8_LAS unsigned*)(lds + (bufoff) + ldsw + _i * 8192), 16, 0, 0); } while (0)
#define PG8_LDA(dst, b, h) do { _Pragma("unroll") for (int m = 0; m < 4; ++m) _Pragma("unroll") for (int k = 0; k < 2; ++k) dst[m][k] = *(const PG8_LAS bf16x8*)(lds + PG8_SA(b, h) + aoff + m * 2048 + k * 1024); } while (0)
#define PG8_LDB(dst, b, h) do { _Pragma("unroll") for (int n = 0; n < 2; ++n) _Pragma("unroll") for (int k = 0; k < 2; ++k) dst[n][k] = *(const PG8_LAS bf16x8*)(lds + PG8_SB(b, h) + boff + n * 2048 + k * 1024); } while (0)
#define PG8_MMA(ai, bj, At, Bt) do { __builtin_amdgcn_s_setprio(1); _Pragma("unroll") for (int m = 0; m < 4; ++m) _Pragma("unroll") for (int n = 0; n < 2; ++n) _Pragma("unroll") for (int k = 0; k < 2; ++k) \
        acc[ai][bj][m][n] = __builtin_amdgcn_mfma_f32_16x16x32_bf16(Bt[n][k], At[m][k], acc[ai][bj][m][n], 0, 0, 0); __builtin_amdgcn_s_setprio(0); } while (0)
#define PG8_WAIT_V(n) asm volatile("s_waitcnt vmcnt(" #n ")" ::: "memory")
#define PG8_WAIT_L(n) asm volatile("s_waitcnt lgkmcnt(" #n ")" ::: "memory")
#define PG8_BAR __builtin_amdgcn_s_barrier()
#define PG8_SCHED __builtin_amdgcn_sched_barrier(0)
    Unit cur, nxt; int ui = 0;
    if (!S.next(0, cur)) return;
    f32x4 acc[2][2][4][2];
#pragma unroll
    for (int a = 0; a < 2; ++a)
#pragma unroll
        for (int b = 0; b < 2; ++b)
#pragma unroll
            for (int m = 0; m < 4; ++m)
#pragma unroll
                for (int n = 0; n < 2; ++n) acc[a][b][m][n] = (f32x4){0.f, 0.f, 0.f, 0.f};
    bf16x8 At[4][2], B0[2][2], B1[2][2];
    const char* cA = (const char*)g.A + (size_t)cur.pm * tstep; const char* cB = (const char*)g.Bt + (size_t)cur.pn * tstep;
    S.a_ready(cur);
    if constexpr (SP2) {
        PG8_STAGE(PG8_SB(0, 0), cB, voffB); PG8_STAGE(PG8_SB(0, 1), cB + hstep, voffB); PG8_STAGE(PG8_SA(0, 0), cA, voffA); PG8_STAGE(PG8_SA(0, 1), cA + hstep, voffA);
        if (wr == 1) PG8_BAR;
        PG8_WAIT_V(2); PG8_BAR;
        PG8_STAGE(PG8_SB(1, 0), cB + kstep, voffB); PG8_STAGE(PG8_SA(1, 0), cA + kstep, voffA); PG8_STAGE(PG8_SB(1, 1), cB + hstep + kstep, voffB);
        PG8_WAIT_V(6); PG8_BAR;
    } else {
        PG8_STAGE(PG8_SB(0, 0), cB, voffB); PG8_STAGE(PG8_SA(0, 0), cA, voffA); PG8_STAGE(PG8_SB(0, 1), cB + hstep, voffB); PG8_STAGE(PG8_SA(0, 1), cA + hstep, voffA);
        if (wr == 1) PG8_BAR;
        PG8_WAIT_V(4); PG8_BAR;
        PG8_STAGE(PG8_SB(1, 0), cB + kstep, voffB); PG8_STAGE(PG8_SA(1, 0), cA + kstep, voffA); PG8_STAGE(PG8_SB(1, 1), cB + hstep + kstep, voffB);
        PG8_WAIT_V(6); PG8_BAR;
    }
    for (;;) {
        const bool has_next = S.next(ui + 1, nxt);
        const char* nA = has_next ? (const char*)g.A + (size_t)nxt.pm * tstep : cA; const char* nB = has_next ? (const char*)g.Bt + (size_t)nxt.pn * tstep : cB;
        for (int t = 0; t < nt; t += 2) {
            const bool last = (t == nt - 2);
            const char* a1 = cA + (size_t)(t + 1) * kstep;
            const char* a2 = last ? nA : cA + (size_t)(t + 2) * kstep; const char* b2 = last ? nB : cB + (size_t)(t + 2) * kstep;
            const char* a3 = a2 + kstep; const char* b3 = b2 + kstep;
            if (last && has_next) S.a_ready(nxt);
            if constexpr (Epi::MIDK > 0) { if (t == Epi::MIDK) E.mid(acc, cur, wr, wc, fr, fq); }
            if constexpr (SP2) {
            PG8_LDB(B0, 0, 0); PG8_LDB(B1, 0, 1); PG8_SCHED; PG8_LDA(At, 0, 0); PG8_STAGE(PG8_SA(1, 1), a1 + hstep, voffA);
            PG8_WAIT_V(8); PG8_WAIT_L(0); PG8_BAR; PG8_MMA(0, 0, At, B0); PG8_MMA(0, 1, At, B1); PG8_BAR; PG8_SCHED;
            PG8_LDA(At, 0, 1); PG8_STAGE(PG8_SB(0, 0), b2, voffB); PG8_STAGE(PG8_SB(0, 1), b2 + hstep, voffB); PG8_STAGE(PG8_SA(0, 0), a2, voffA);
            PG8_WAIT_V(8); PG8_WAIT_L(0); PG8_BAR; PG8_MMA(1, 0, At, B0); PG8_MMA(1, 1, At, B1); PG8_BAR; PG8_SCHED;
            PG8_LDB(B0, 1, 0); PG8_LDB(B1, 1, 1); PG8_SCHED; PG8_LDA(At, 1, 0); PG8_STAGE(PG8_SA(0, 1), a2 + hstep, voffA);
            PG8_WAIT_V(8); PG8_WAIT_L(0); PG8_BAR; PG8_MMA(0, 0, At, B0); PG8_MMA(0, 1, At, B1); PG8_BAR; PG8_SCHED;
            PG8_LDA(At, 1, 1); PG8_STAGE(PG8_SB(1, 0), b3, voffB); PG8_STAGE(PG8_SB(1, 1), b3 + hstep, voffB); PG8_STAGE(PG8_SA(1, 0), a3, voffA);
            PG8_WAIT_V(8); PG8_WAIT_L(0); PG8_BAR; PG8_MMA(1, 0, At, B0); PG8_MMA(1, 1, At, B1); PG8_BAR; PG8_SCHED;
            } else {
            PG8_LDB(B0, 0, 0); PG8_SCHED; PG8_LDA(At, 0, 0); PG8_STAGE(PG8_SA(1, 1), a1 + hstep, voffA);
            PG8_WAIT_L(8); PG8_BAR; PG8_WAIT_L(0); PG8_MMA(0, 0, At, B0); PG8_BAR; PG8_SCHED;
            PG8_LDB(B1, 0, 1); PG8_STAGE(PG8_SB(0, 0), b2, voffB);
            PG8_BAR; PG8_WAIT_L(0); PG8_MMA(0, 1, At, B1); PG8_BAR;
            PG8_LDA(At, 0, 1); PG8_STAGE(PG8_SA(0, 0), a2, voffA);
            PG8_BAR; PG8_WAIT_L(0); PG8_MMA(1, 0, At, B0); PG8_BAR; PG8_SCHED;
            PG8_STAGE(PG8_SB(0, 1), b2 + hstep, voffB);
            PG8_WAIT_V(6); PG8_BAR; PG8_MMA(1, 1, At, B1); PG8_BAR;
            PG8_LDB(B0, 1, 0); PG8_SCHED; PG8_LDA(At, 1, 0); PG8_STAGE(PG8_SA(0, 1), a2 + hstep, voffA);
            PG8_WAIT_L(8); PG8_BAR; PG8_WAIT_L(0); PG8_MMA(0, 0, At, B0); PG8_BAR; PG8_SCHED;
            PG8_LDB(B1, 1, 1); PG8_STAGE(PG8_SB(1, 0), b3, voffB);
            PG8_BAR; PG8_WAIT_L(0); PG8_MMA(0, 1, At, B1); PG8_BAR;
            PG8_LDA(At, 1, 1); PG8_STAGE(PG8_SA(1, 0), a3, voffA);
            PG8_BAR; PG8_WAIT_L(0); PG8_MMA(1, 0, At, B0); PG8_BAR; PG8_SCHED;
            PG8_STAGE(PG8_SB(1, 1), b3 + hstep, voffB);
            PG8_WAIT_V(6); PG8_BAR; PG8_MMA(1, 1, At, B1); PG8_BAR;
            }
        }
        if constexpr (ALIGN_EPI) { if (wr == 0) PG8_BAR; }
        if constexpr (!Epi::AFTER_DRAIN) { E(acc, cur, wr, wc, fr, fq); S.done(cur); }
        if (!has_next) break;
#pragma unroll
        for (int a = 0; a < 2; ++a)
#pragma unroll
            for (int b = 0; b < 2; ++b)
#pragma unroll
                for (int m = 0; m < 4; ++m)
#pragma unroll
                    for (int n = 0; n < 2; ++n) acc[a][b][m][n] = (f32x4){0.f, 0.f, 0.f, 0.f};
        cur = nxt; cA = nA; cB = nB; ++ui;
        if constexpr (ALIGN_EPI) { if (wr == 1) PG8_BAR; }
    }
    PG8_WAIT_V(0);
    if constexpr (!ALIGN_EPI) { if (wr == 0) PG8_BAR; }
    PG8_BAR;
    if constexpr (Epi::AFTER_DRAIN) { E.fused(acc, cur, wr, wc, fr, fq, lds, wid, lane); S.done(cur); }
#undef PG8_SA
#undef PG8_SB
#undef PG8_STAGE
#undef PG8_LDA
#undef PG8_LDB
#undef PG8_MMA
#undef PG8_WAIT_V
#undef PG8_WAIT_L
#undef PG8_BAR
#undef PG8_SCHED
}
}
#define GAS __attribute__((address_space(1)))
#define LAS __attribute__((address_space(3)))
typedef unsigned short bf16;
typedef unsigned v4u __attribute__((ext_vector_type(4)));
typedef float f32x4 __attribute__((ext_vector_type(4)));
typedef short bf16x8 __attribute__((ext_vector_type(8)));
typedef GAS unsigned gu32;
typedef GAS unsigned long long gu64;
#define RLX_AGENT __ATOMIC_RELAXED, __HIP_MEMORY_SCOPE_AGENT
#define LDS_WAIT() asm volatile("s_waitcnt lgkmcnt(0)" ::: "memory")
#define VM_WAIT() asm volatile("s_waitcnt vmcnt(0)" ::: "memory")
__device__ __forceinline__ unsigned long long rt() { return __builtin_amdgcn_s_memrealtime(); }
__device__ __forceinline__ unsigned f2bf(float f) { unsigned u = __builtin_bit_cast(unsigned, f); return (u + 0x7fffu + ((u >> 16) & 1u)) >> 16; }
__device__ __forceinline__ unsigned pk2(float lo, float hi) { return f2bf(lo) | (f2bf(hi) << 16); }

#define XB_TMO      128
#define XB_XCNT(j)  (256  + 64 * (j))
#define XB_XSUB(j)  (1280 + 64 * (j))
#define XB_XGEN(j)  (2304 + 64 * (j))
#define XB_TOP      3328
#define XB_TOPGEN   3392
#define XCD_BAR_WORDS 3456
#define XB_SPIN_CAP (1u << 18)

__device__ __forceinline__ unsigned xb_ld(unsigned* p)              { return __hip_atomic_load(p, __ATOMIC_RELAXED, __HIP_MEMORY_SCOPE_AGENT); }
__device__ __forceinline__ unsigned xb_add(unsigned* p, unsigned v) { return __hip_atomic_fetch_add(p, v, __ATOMIC_RELAXED, __HIP_MEMORY_SCOPE_AGENT); }
__device__ __forceinline__ unsigned xb_xcc_id() { return (unsigned)__builtin_amdgcn_s_getreg((3 << 11) | 20) & 0xFu; }
#define XB_SPIN(cond, bar) do { unsigned _sp = 0; while (cond) { __builtin_amdgcn_s_sleep(1); \
    if ((++_sp & 255u) == 0u) { if (xb_ld(&(bar)[XB_TMO])) break; if (_sp > XB_SPIN_CAP) { atomicAdd(&(bar)[XB_TMO], 1u); break; } } } } while (0)

struct XcdBarrier {
    unsigned* bar; unsigned x;
    volatile LAS unsigned* st;
};

__device__ __forceinline__ XcdBarrier xcd_barrier_post(unsigned* bar, volatile LAS unsigned* st) {
    XcdBarrier b; b.bar = bar; b.x = xb_xcc_id(); b.st = st;
    if (threadIdx.x == 0) (void)xb_add(&bar[XB_XCNT(b.x)], 1u);
    return b;
}
__device__ __forceinline__ void xcd_barrier_complete(unsigned* bar, unsigned x, unsigned& nloc, unsigned& nx) {
    const unsigned G = gridDim.x * gridDim.y * gridDim.z;
    unsigned sum, cnt, mine, sp = 0u;
    for (;;) {
        sum = 0u; cnt = 0u; mine = 0u;
#pragma unroll
        for (unsigned j = 0; j < 16; ++j) { const unsigned c = xb_ld(&bar[XB_XCNT(j)]); sum += c; cnt += (c > 0u) ? 1u : 0u; mine = (j == x) ? c : mine; }
        if (sum == G) break;
        __builtin_amdgcn_s_sleep(1);
        if ((++sp & 255u) == 0u) { if (xb_ld(&bar[XB_TMO])) break; if (sp > XB_SPIN_CAP) { atomicAdd(&bar[XB_TMO], 1u); break; } }
    }
    nloc = mine > 0u ? mine : 1u; nx = cnt > 0u ? cnt : 1u;
}

__device__ __forceinline__ void xcd_barrier(const XcdBarrier& b) {
    asm volatile("s_waitcnt vmcnt(0)" ::: "memory");
    __syncthreads();
    if (threadIdx.x == 0) {
        unsigned* bar = b.bar;
        __builtin_amdgcn_s_waitcnt(0);
        unsigned nloc = b.st[0], nx = b.st[1];
        if (nloc == 0u) { xcd_barrier_complete(bar, b.x, nloc, nx); b.st[0] = nloc; b.st[1] = nx; }
        const unsigned old = xb_add(&bar[XB_XSUB(b.x)], 1u);
        const unsigned gen = old / nloc;
        if (old + 1u == (gen + 1u) * nloc) {
            __builtin_amdgcn_fence(__ATOMIC_RELEASE, "agent");
            asm volatile("s_waitcnt vmcnt(0)" ::: "memory");
            const unsigned og = xb_add(&bar[XB_TOP], 1u);
            const unsigned tg = og / nx;
            if (og + 1u == (tg + 1u) * nx) xb_add(&bar[XB_TOPGEN], 1u);
            else XB_SPIN(xb_ld(&bar[XB_TOPGEN]) == tg, bar);
            __builtin_amdgcn_fence(__ATOMIC_ACQUIRE, "agent");
            xb_add(&bar[XB_XGEN(b.x)], 1u);
            asm volatile("s_waitcnt vmcnt(0)" ::: "memory");
        } else {
            XB_SPIN(xb_ld(&bar[XB_XGEN(b.x)]) == gen, bar);
            __builtin_amdgcn_fence(__ATOMIC_ACQUIRE, "agent");
            asm volatile("s_waitcnt vmcnt(0)" ::: "memory");
        }
    }
    __syncthreads();
}

#ifndef MK_N_LAUNCHES
#define MK_N_LAUNCHES 11
#endif
constexpr int NWAVES = 8, NPHASES = 11;
constexpr int N_LAUNCHES = MK_N_LAUNCHES;
constexpr int SEQ = 8192, DM = 2048, AW = 2048, BW = 1024, INC = 9216, FF = 5632, FF2 = 11264, NMOD = 12288, KAB = 3072;
constexpr float EPS = 1e-6f;
constexpr size_t MiB = 1u << 20;
constexpr size_t WS_CTL = 0, CTL_ZERO_BYTES = 1 * MiB;
constexpr size_t WS_MOD = 64 * 1024, WS_STATS = 128 * 1024;
constexpr size_t WS_VEC = 1 * MiB;
constexpr size_t WS_WIN = 2 * MiB, WS_WAB = 38 * MiB, WS_WOUT = 50 * MiB, WS_WUP = 58 * MiB, WS_WDN = 102 * MiB, WS_WPOOL = 124 * MiB, WS_WSP = WS_WPOOL + 512 * 1024;
constexpr size_t WS_H1 = 125 * MiB, WS_U = 157 * MiB, WS_V = 189 * MiB, WS_P = 221 * MiB, WS_GA = 237 * MiB, WS_GB = 269 * MiB;
constexpr size_t WS_UP = 125 * MiB, WS_SGPB = 301 * MiB, WS_MERGED = 349 * MiB, WS_ACT = 301 * MiB, WS_MIX = 125 * MiB, WS_H2 = 301 * MiB, WS_Y = 125 * MiB;
constexpr size_t WS_END = 389 * MiB;
constexpr int CW_BAR = 4096;
static_assert((CW_BAR + XCD_BAR_WORDS) * 4 <= (int)WS_MOD && WS_MOD + NMOD * 4 <= WS_STATS && WS_STATS + SEQ * 8 <= CTL_ZERO_BYTES, "CTL map");
constexpr int RING_OFF = 0, RING_BYTES = 131072, LDSCTL_OFF = RING_BYTES, MISC_OFF = LDSCTL_OFF + 320, LDS_BYTES = 147456;

__device__ __forceinline__ float wave_sum(float v) {
#pragma unroll
    for (int o = 1; o < 64; o <<= 1) v += __shfl_xor(v, o);
    return v;
}
__device__ __forceinline__ float sigm(float z) { return __builtin_amdgcn_rcpf(1.0f + __builtin_amdgcn_exp2f(z * -1.44269504089f)); }
__device__ __forceinline__ float gelu_t(float x) { const float z = x * (1.5957691216f + 0.0713548163f * x * x); return x * sigm(z); }
__device__ __forceinline__ float bflo(unsigned w) { return __builtin_bit_cast(float, w << 16); }
__device__ __forceinline__ float bfhi(unsigned w) { return __builtin_bit_cast(float, w & 0xffff0000u); }

__device__ __forceinline__ void p0_mod_gemv(const float* c, const float* w_ada, const float* b_ada, float* MOD, int gw, int NGW, int lane) {
    constexpr int NCG = NMOD / 256, NKG = DM / 16;
    for (int it = gw; it < NCG * NKG; it += NGW) {
        const int cg = it % NCG, kg = it / NCG, k0 = kg * 16, col = cg * 256 + lane * 4;
        float cv = c[k0 + (lane & 15)]; cv = cv * sigm(cv);
        f32x4 a = (f32x4){0.f, 0.f, 0.f, 0.f};
#pragma unroll
        for (int kk = 0; kk < 16; ++kk) { const float s = __shfl(cv, kk); const f32x4 w = *(const f32x4*)(w_ada + (size_t)(k0 + kk) * NMOD + col); a += w * s; }
        if (kg == 0) a += *(const f32x4*)(b_ada + col);
        atomicAdd(MOD + col + 0, a[0]); atomicAdd(MOD + col + 1, a[1]); atomicAdd(MOD + col + 2, a[2]); atomicAdd(MOD + col + 3, a[3]);
    }
}
__device__ __forceinline__ void p0_transpose_item(const float* W, int N, bf16* WT, int dpitch, int koff, LAS float* scr, int item, int lane) {
    const int nblk = N / 32, kb = item / nblk, nb = item % nblk, k0 = 64 * kb, n0 = 32 * nb;
#pragma unroll 8
    for (int i = 0; i < 32; ++i) { const int kk = 2 * i + (lane >> 5); scr[kk * 33 + (lane & 31)] = W[(size_t)(k0 + kk) * N + n0 + (lane & 31)]; }
    LDS_WAIT(); asm volatile("" ::: "memory");
    const int c = lane & 7;
#pragma unroll
    for (int j = 0; j < 4; ++j) { const int n = (lane >> 3) + 8 * j; const LAS float* s = scr + (8 * c) * 33 + n;
        v4u o; o.x = pk2(s[0 * 33], s[1 * 33]); o.y = pk2(s[2 * 33], s[3 * 33]); o.z = pk2(s[4 * 33], s[5 * 33]); o.w = pk2(s[6 * 33], s[7 * 33]);
        *(v4u*)(WT + (size_t)(n0 + n) * dpitch + koff + k0 + 8 * c) = o; }
    LDS_WAIT(); asm volatile("" ::: "memory");
}

__device__ __forceinline__ void p3_spatial(LAS unsigned char* lds, int n, int h, const bf16* V, const bf16* U, const float* stats, const float* ln_g, const float* ln_b,
                                           const bf16* Wsp, const float* b_sp, bf16* SGPB, int tid, int lane, int wave) {
    LAS bf16* vnT = (LAS bf16*)lds;
    const int t0 = n * 128, d0 = h * 256;
    {   const int j = tid & 127, qb = tid >> 7;
        const float s = stats[2 * (t0 + j)], q = stats[2 * (t0 + j) + 1];
        const float mu = s * (1.0f / AW), var = fmaxf(q * (1.0f / AW) - mu * mu, 0.f), rstd = 1.0f / sqrtf(var + EPS);
        const bf16* vrow = V + (size_t)(t0 + j) * AW + d0;
#pragma unroll
        for (int it = 0; it < 8; ++it) { const int q8 = (qb + 4 * it) * 8;
            const v4u raw = *(const v4u*)(vrow + q8);
            const f32x4 g0 = *(const f32x4*)(ln_g + d0 + q8), g1 = *(const f32x4*)(ln_g + d0 + q8 + 4), b0 = *(const f32x4*)(ln_b + d0 + q8), b1 = *(const f32x4*)(ln_b + d0 + q8 + 4);
            float v[8] = {bflo(raw.x), bfhi(raw.x), bflo(raw.y), bfhi(raw.y), bflo(raw.z), bfhi(raw.z), bflo(raw.w), bfhi(raw.w)};
            const float g[8] = {g0[0], g0[1], g0[2], g0[3], g1[0], g1[1], g1[2], g1[3]}, b[8] = {b0[0], b0[1], b0[2], b0[3], b1[0], b1[1], b1[2], b1[3]};
#pragma unroll
            for (int e = 0; e < 8; ++e) vnT[(q8 + e) * 136 + j] = (bf16)f2bf((v[e] - mu) * rstd * g[e] + b[e]); }
    }
    __syncthreads();
    const int fr = lane & 15, fq = lane >> 4;
    f32x4 acc[2][8];
#pragma unroll
    for (int a = 0; a < 2; ++a)
#pragma unroll
        for (int b = 0; b < 8; ++b) acc[a][b] = (f32x4){0.f, 0.f, 0.f, 0.f};
    const bf16* wbase = Wsp + (size_t)h * 16384;
#pragma unroll
    for (int ks = 0; ks < 4; ++ks) {
        bf16x8 a[2];
#pragma unroll
        for (int dbi = 0; dbi < 2; ++dbi) a[dbi] = *(const LAS bf16x8*)(vnT + (16 * (2 * wave + dbi) + fr) * 136 + 32 * ks + 8 * fq);
#pragma unroll
        for (int ib = 0; ib < 8; ++ib) {
            if (32 * ks <= 16 * ib + 15) {
                const bf16x8 b = *(const bf16x8*)(wbase + (16 * ib + fr) * 128 + 32 * ks + 8 * fq);
#pragma unroll
                for (int dbi = 0; dbi < 2; ++dbi) acc[dbi][ib] = __builtin_amdgcn_mfma_f32_16x16x32_bf16(a[dbi], b, acc[dbi][ib], 0, 0, 0);
            }
        }
    }
#pragma unroll
    for (int ib = 0; ib < 8; ++ib) { const int i = 16 * ib + fr; const float bs = b_sp[h * 128 + i];
#pragma unroll
        for (int dbi = 0; dbi < 2; ++dbi) { const int d = d0 + 16 * (2 * wave + dbi) + 4 * fq;
            const uint2 uu = *(const uint2*)(U + (size_t)(t0 + i) * AW + d); const f32x4 m = acc[dbi][ib] + bs;
            uint2 o; o.x = pg8::cvt_pk_bf16(bflo(uu.x) * m[0], bfhi(uu.x) * m[1]); o.y = pg8::cvt_pk_bf16(bflo(uu.y) * m[2], bfhi(uu.y) * m[3]);
            *(uint2*)(SGPB + (size_t)(t0 + i) * KAB + d) = o; } }
}
__device__ __forceinline__ void p3_pool(LAS unsigned char* lds, int r, int gi, const bf16* P, const bf16* WpT, const float* pscale, bf16* SGPB, int tid, int lane, int wave) {
    LAS bf16* Ap = (LAS bf16*)lds;
    const int t0 = r * 128, win = 2 << gi;
    {   const int q8 = (tid & 31) * 8;
#pragma unroll 2
        for (int it = 0; it < 8; ++it) { const int tl = (tid >> 5) + 16 * it, t = t0 + tl, cnt = (t + 1 < win) ? (t + 1) : win;
            float sum[8] = {0.f, 0.f, 0.f, 0.f, 0.f, 0.f, 0.f, 0.f}, self[8];
            for (int sI = 0; sI < cnt; ++sI) { const v4u raw = *(const v4u*)(P + (size_t)(t - sI) * BW + gi * 256 + q8);
                const float v[8] = {bflo(raw.x), bfhi(raw.x), bflo(raw.y), bfhi(raw.y), bflo(raw.z), bfhi(raw.z), bflo(raw.w), bfhi(raw.w)};
#pragma unroll
                for (int e = 0; e < 8; ++e) { sum[e] += v[e]; if (sI == 0) self[e] = v[e]; } }
            const float inv = 1.0f / (float)cnt;
            v4u o; o.x = pk2(sum[0] * inv - self[0], sum[1] * inv - self[1]); o.y = pk2(sum[2] * inv - self[2], sum[3] * inv - self[3]);
            o.z = pk2(sum[4] * inv - self[4], sum[5] * inv - self[5]); o.w = pk2(sum[6] * inv - self[6], sum[7] * inv - self[7]);
            *(LAS v4u*)(Ap + tl * 264 + q8) = o; }
    }
    __syncthreads();
    const int fr = lane & 15, fq = lane >> 4;
    f32x4 acc[2][8];
#pragma unroll
    for (int a = 0; a < 2; ++a)
#pragma unroll
        for (int b = 0; b < 8; ++b) acc[a][b] = (f32x4){0.f, 0.f, 0.f, 0.f};
    const bf16* wbase = WpT + (size_t)gi * 65536;
#pragma unroll
    for (int ks = 0; ks < 8; ++ks) {
        bf16x8 a[2];
#pragma unroll
        for (int ebi = 0; ebi < 2; ++ebi) a[ebi] = *(const bf16x8*)(wbase + (16 * (2 * wave + ebi) + fr) * 256 + 32 * ks + 8 * fq);
#pragma unroll
        for (int tb = 0; tb < 8; ++tb) { const bf16x8 b = *(const LAS bf16x8*)(Ap + (16 * tb + fr) * 264 + 32 * ks + 8 * fq);
#pragma unroll
            for (int ebi = 0; ebi < 2; ++ebi) acc[ebi][tb] = __builtin_amdgcn_mfma_f32_16x16x32_bf16(a[ebi], b, acc[ebi][tb], 0, 0, 0); }
    }
#pragma unroll
    for (int ebi = 0; ebi < 2; ++ebi) { const int e = 16 * (2 * wave + ebi) + 4 * fq; const f32x4 sc = *(const f32x4*)(pscale + gi * 256 + e);
#pragma unroll
        for (int tb = 0; tb < 8; ++tb) { const f32x4 m = acc[ebi][tb] * sc;
            uint2 o; o.x = pg8::cvt_pk_bf16(m[0], m[1]); o.y = pg8::cvt_pk_bf16(m[2], m[3]);
            *(uint2*)(SGPB + (size_t)(t0 + 16 * tb + fr) * KAB + AW + gi * 256 + e) = o; } }
}

struct Params { const float* in[22]; float* out; unsigned char* ws; int ph_lo, ph_hi; };
enum { I_X = 0, I_C, I_WADA, I_BADA, I_GPREMIX, I_GPOSTMIX, I_WIN, I_LNG, I_LNB, I_WSP, I_BSP, I_WPOOL, I_PSCALE, I_WA, I_WB, I_WOUT, I_GPREFFN, I_GPOSTFFN, I_WUP, I_CONVW, I_CONVB, I_WDN };

__global__ void __launch_bounds__(NWAVES * 64, 2) fwd_megakernel(Params p) {
    extern __shared__ __attribute__((aligned(16))) unsigned char lds_raw[];
    LAS unsigned char* lds = (LAS unsigned char*)lds_raw;
    volatile LAS unsigned* MISC = (volatile LAS unsigned*)(lds + MISC_OFF);
    const int tid = threadIdx.x, lane = tid & 63, wave = __builtin_amdgcn_readfirstlane(tid >> 6);
    const int G = gridDim.x, bx = blockIdx.x, vcu = (G % 8 == 0) ? (bx % 8) * (G / 8) + bx / 8 : bx;
    const int gw = vcu * NWAVES + wave, NGW = G * NWAVES;
    unsigned char* ws = p.ws;
    for (int u = tid; u < (LDS_BYTES - LDSCTL_OFF) / 4; u += NWAVES * 64) ((LAS unsigned*)(lds + LDSCTL_OFF))[u] = 0u;
    __syncthreads();
    const int lo = p.ph_lo, hi = p.ph_hi;
    XcdBarrier bar; bar.bar = (unsigned*)(ws + WS_CTL) + CW_BAR; bar.x = 0; bar.st = nullptr;
    if (hi - lo > 1) bar = xcd_barrier_post((unsigned*)(ws + WS_CTL) + CW_BAR, MISC + 8);
#define IN(k) (lo <= (k) && (k) < hi)
#define SEAM(k) do { if (IN(k) && IN((k) + 1)) xcd_barrier(bar); } while (0)

    float* MOD = (float*)(ws + WS_MOD); float* STATS = (float*)(ws + WS_STATS); float* VEC = (float*)(ws + WS_VEC);
    bf16 *Win_t = (bf16*)(ws + WS_WIN), *Wab_t = (bf16*)(ws + WS_WAB), *Wout_t = (bf16*)(ws + WS_WOUT), *Wup_t = (bf16*)(ws + WS_WUP), *Wdn_t = (bf16*)(ws + WS_WDN), *WpT = (bf16*)(ws + WS_WPOOL), *Wsp = (bf16*)(ws + WS_WSP);
    bf16 *H1 = (bf16*)(ws + WS_H1), *Ub = (bf16*)(ws + WS_U), *Vb = (bf16*)(ws + WS_V), *Pb = (bf16*)(ws + WS_P), *GA = (bf16*)(ws + WS_GA), *GB = (bf16*)(ws + WS_GB);
    bf16 *UP = (bf16*)(ws + WS_UP), *SGPB = (bf16*)(ws + WS_SGPB), *MERGED = (bf16*)(ws + WS_MERGED), *ACT = (bf16*)(ws + WS_ACT), *H2 = (bf16*)(ws + WS_H2);
    float *MIX = (float*)(ws + WS_MIX), *Y = (float*)(ws + WS_Y);
    const float* x = p.in[I_X]; float* out = p.out;

    if (IN(0)) {
        p0_mod_gemv(p.in[I_C], p.in[I_WADA], p.in[I_BADA], MOD, gw, NGW, lane);
        LAS float* scr = (LAS float*)(lds + RING_OFF + wave * 16384);
        constexpr int I_IN = (DM / 64) * (INC / 32), I_A = (AW / 64) * (DM / 32), I_B = (BW / 64) * (DM / 32), I_O = (DM / 64) * (DM / 32), I_U = (DM / 64) * (FF2 / 32), I_D = (FF / 64) * (DM / 32), I_P = (256 / 64) * (256 / 32);
        constexpr int NITEMS = I_IN + I_A + I_B + I_O + I_U + I_D + 4 * I_P;
        for (int it = gw; it < NITEMS; it += NGW) {
            int r = it;
            if (r < I_IN) { p0_transpose_item(p.in[I_WIN], INC, Win_t, DM, 0, scr, r, lane); continue; } r -= I_IN;
            if (r < I_A) { p0_transpose_item(p.in[I_WA], DM, Wab_t, KAB, 0, scr, r, lane); continue; } r -= I_A;
            if (r < I_B) { p0_transpose_item(p.in[I_WB], DM, Wab_t, KAB, AW, scr, r, lane); continue; } r -= I_B;
            if (r < I_O) { p0_transpose_item(p.in[I_WOUT], DM, Wout_t, DM, 0, scr, r, lane); continue; } r -= I_O;
            if (r < I_U) { p0_transpose_item(p.in[I_WUP], FF2, Wup_t, DM, 0, scr, r, lane); continue; } r -= I_U;
            if (r < I_D) { p0_transpose_item(p.in[I_WDN], DM, Wdn_t, FF, 0, scr, r, lane); continue; } r -= I_D;
            { const int gi = r / I_P; p0_transpose_item(p.in[I_WPOOL] + (size_t)gi * 65536, 256, WpT + (size_t)gi * 65536, 256, 0, scr, r % I_P, lane); }
        }
        for (int idx = gw * 64 + lane; idx < 8 * 128 * 128; idx += NGW * 64) { const int i = (idx >> 7) & 127, j = idx & 127; Wsp[idx] = (bf16)((j <= i) ? f2bf(p.in[I_WSP][idx]) : 0u); }
    }
    SEAM(0);
    if (IN(1)) {
        if (bx == 0) for (int cc = tid; cc < DM; cc += NWAVES * 64) {
            VEC[cc] = MOD[2 * DM + cc] * p.in[I_GPOSTMIX][cc];
            VEC[DM + cc] = p.in[I_GPREFFN][cc] * (1.0f + MOD[4 * DM + cc]);
            VEC[2 * DM + cc] = MOD[3 * DM + cc];
            VEC[3 * DM + cc] = MOD[5 * DM + cc] * p.in[I_GPOSTFFN][cc]; }
        f32x4 ca[8], cb[8];
#pragma unroll
        for (int j = 0; j < 8; ++j) { const int cc = 4 * lane + 256 * j; const f32x4 g = *(const f32x4*)(p.in[I_GPREMIX] + cc), sc = *(const f32x4*)(MOD + DM + cc); ca[j] = g * (sc + 1.0f); cb[j] = *(const f32x4*)(MOD + cc); }
        for (int m = gw; m < SEQ; m += NGW) {
            const f32x4* xr = (const f32x4*)(x + (size_t)m * DM) + lane; f32x4 v[8]; float ss = 0.f;
#pragma unroll
            for (int j = 0; j < 8; ++j) { v[j] = xr[64 * j]; ss += (v[j][0] * v[j][0] + v[j][1] * v[j][1]) + (v[j][2] * v[j][2] + v[j][3] * v[j][3]); }
            const float rstd = 1.0f / sqrtf(wave_sum(ss) * (1.0f / DM) + EPS);
            uint2* o8 = (uint2*)(H1 + (size_t)m * DM) + lane;
#pragma unroll
            for (int j = 0; j < 8; ++j) { const f32x4 h = v[j] * rstd * ca[j] + cb[j]; uint2 o; o.x = pk2(h[0], h[1]); o.y = pk2(h[2], h[3]); o8[64 * j] = o; }
        }
    }
    SEAM(1);
    if (IN(2)) {
        pg8::Gemm g{H1, Win_t, SEQ, INC, DM}; pg8::StaticOrder S; S.init(SEQ, INC, G, bx);
        pg8::EpiIn E{Ub, Vb, Pb, GA, GB, STATS};
        pg8::gemm_phase<pg8::EpiIn, pg8::StaticOrder, true, true>(lds + RING_OFF, g, S, E);
    }
    SEAM(2);
    if (IN(3)) {
        for (int u = vcu; u < 768; u += G) {
            __syncthreads();
            if (u < 512) p3_spatial(lds + RING_OFF, u >> 3, u & 7, Vb, Ub, STATS, p.in[I_LNG], p.in[I_LNB], Wsp, p.in[I_BSP], SGPB, tid, lane, wave);
            else p3_pool(lds + RING_OFF, (u - 512) >> 2, (u - 512) & 3, Pb, WpT, p.in[I_PSCALE], SGPB, tid, lane, wave);
        }
        __syncthreads();
    }
    SEAM(3);
    if (IN(4)) {
        pg8::Gemm g{SGPB, Wab_t, SEQ, DM, KAB}; pg8::StaticOrder S; S.init(SEQ, DM, G, bx);
        pg8::EpiMerge E{GA, GB, MERGED};
        pg8::gemm_phase<pg8::EpiMerge, pg8::StaticOrder, true, true>(lds + RING_OFF, g, S, E);
    }
    SEAM(4);
    if (IN(5)) {
        pg8::Gemm g{MERGED, Wout_t, SEQ, DM, DM}; pg8::StaticOrder S; S.init(SEQ, DM, G, bx);
        pg8::EpiF32 E{MIX, DM};
        pg8::gemm_phase<pg8::EpiF32, pg8::StaticOrder, true, true>(lds + RING_OFF, g, S, E);
    }
    SEAM(5);
    if (IN(6)) {
        for (int m = gw; m < SEQ; m += NGW) {
            const f32x4* xr = (const f32x4*)(x + (size_t)m * DM) + lane; const f32x4* mr = (const f32x4*)(MIX + (size_t)m * DM) + lane; f32x4 v[8], w[8]; float ss = 0.f;
#pragma unroll
            for (int j = 0; j < 8; ++j) { v[j] = xr[64 * j]; w[j] = mr[64 * j]; ss += (w[j][0] * w[j][0] + w[j][1] * w[j][1]) + (w[j][2] * w[j][2] + w[j][3] * w[j][3]); }
            const float rstd = 1.0f / sqrtf(wave_sum(ss) * (1.0f / DM) + EPS); float s1 = 0.f;
            f32x4* o4 = (f32x4*)(out + (size_t)m * DM) + lane;
#pragma unroll
            for (int j = 0; j < 8; ++j) { const f32x4 g1 = *((const f32x4*)VEC + lane + 64 * j); v[j] = v[j] + g1 * (w[j] * rstd); o4[64 * j] = v[j];
                s1 += (v[j][0] * v[j][0] + v[j][1] * v[j][1]) + (v[j][2] * v[j][2] + v[j][3] * v[j][3]); }
            const float rstd1 = 1.0f / sqrtf(wave_sum(s1) * (1.0f / DM) + EPS);
            uint2* o8 = (uint2*)(H2 + (size_t)m * DM) + lane;
#pragma unroll
            for (int j = 0; j < 8; ++j) { const f32x4 a2 = *((const f32x4*)(VEC + DM) + lane + 64 * j), b2 = *((const f32x4*)(VEC + 2 * DM) + lane + 64 * j);
                const f32x4 h = v[j] * rstd1 * a2 + b2; uint2 o; o.x = pk2(h[0], h[1]); o.y = pk2(h[2], h[3]); o8[64 * j] = o; }
        }
    }
    SEAM(6);
    if (IN(7)) {
        pg8::Gemm g{H2, Wup_t, SEQ, FF2, DM}; pg8::StaticOrder S; S.init(SEQ, FF2, G, bx);
        pg8::EpiBf16Plain E{UP, FF2};
        pg8::gemm_phase<pg8::EpiBf16Plain, pg8::StaticOrder, true, true>(lds + RING_OFF, g, S, E);
    }
    SEAM(7);
    if (IN(8)) {
        const float* cw = p.in[I_CONVW]; const float* cbv = p.in[I_CONVB];
        const int NT = G * NWAVES * 64, gt = vcu * (NWAVES * 64) + tid;
        for (int idx = gt; idx < SEQ * (FF / 8); idx += NT) {
            const int q8 = (idx % (FF / 8)) * 8, t = idx / (FF / 8);
            float a[8], gg[8];
            { const f32x4 b0 = *(const f32x4*)(cbv + q8), b1 = *(const f32x4*)(cbv + q8 + 4), c0 = *(const f32x4*)(cbv + FF + q8), c1 = *(const f32x4*)(cbv + FF + q8 + 4);
#pragma unroll
              for (int e = 0; e < 4; ++e) { a[e] = b0[e]; a[4 + e] = b1[e]; gg[e] = c0[e]; gg[4 + e] = c1[e]; } }
#pragma unroll
            for (int k = 0; k < 3; ++k) { const int tt = t - 2 + k; if (tt >= 0) {
                const v4u ra = *(const v4u*)(UP + (size_t)tt * FF2 + q8), rg = *(const v4u*)(UP + (size_t)tt * FF2 + FF + q8);
                const f32x4 wa0 = *(const f32x4*)(cw + k * FF2 + q8), wa1 = *(const f32x4*)(cw + k * FF2 + q8 + 4), wg0 = *(const f32x4*)(cw + k * FF2 + FF + q8), wg1 = *(const f32x4*)(cw + k * FF2 + FF + q8 + 4);
                a[0] += wa0[0] * bflo(ra.x); a[1] += wa0[1] * bfhi(ra.x); a[2] += wa0[2] * bflo(ra.y); a[3] += wa0[3] * bfhi(ra.y);
                a[4] += wa1[0] * bflo(ra.z); a[5] += wa1[1] * bfhi(ra.z); a[6] += wa1[2] * bflo(ra.w); a[7] += wa1[3] * bfhi(ra.w);
                gg[0] += wg0[0] * bflo(rg.x); gg[1] += wg0[1] * bfhi(rg.x); gg[2] += wg0[2] * bflo(rg.y); gg[3] += wg0[3] * bfhi(rg.y);
                gg[4] += wg1[0] * bflo(rg.z); gg[5] += wg1[1] * bfhi(rg.z); gg[6] += wg1[2] * bflo(rg.w); gg[7] += wg1[3] * bfhi(rg.w); } }
            v4u o; o.x = pk2(gelu_t(a[0]) * gg[0], gelu_t(a[1]) * gg[1]); o.y = pk2(gelu_t(a[2]) * gg[2], gelu_t(a[3]) * gg[3]);
            o.z = pk2(gelu_t(a[4]) * gg[4], gelu_t(a[5]) * gg[5]); o.w = pk2(gelu_t(a[6]) * gg[6], gelu_t(a[7]) * gg[7]);
            *(v4u*)(ACT + (size_t)t * FF + q8) = o;
        }
    }
    SEAM(8);
    if (IN(9)) {
        pg8::Gemm g{ACT, Wdn_t, SEQ, DM, FF}; pg8::StaticOrder S; S.init(SEQ, DM, G, bx);
        pg8::EpiF32 E{Y, DM};
        pg8::gemm_phase<pg8::EpiF32, pg8::StaticOrder, true, true>(lds + RING_OFF, g, S, E);
    }
    SEAM(9);
    if (IN(10)) {
        for (int m = gw; m < SEQ; m += NGW) {
            f32x4* o4 = (f32x4*)(out + (size_t)m * DM) + lane; const f32x4* yr = (const f32x4*)(Y + (size_t)m * DM) + lane; f32x4 v[8], w[8]; float ss = 0.f;
#pragma unroll
            for (int j = 0; j < 8; ++j) { v[j] = o4[64 * j]; w[j] = yr[64 * j]; ss += (w[j][0] * w[j][0] + w[j][1] * w[j][1]) + (w[j][2] * w[j][2] + w[j][3] * w[j][3]); }
            const float rstd = 1.0f / sqrtf(wave_sum(ss) * (1.0f / DM) + EPS);
#pragma unroll
            for (int j = 0; j < 8; ++j) { const f32x4 g2 = *((const f32x4*)(VEC + 3 * DM) + lane + 64 * j); o4[64 * j] = v[j] + g2 * (w[j] * rstd); }
        }
    }
#undef IN
#undef SEAM
}

extern "C" void kernel_launch(void* const* d_in, const int* in_sizes, int n_in, void* d_out, int out_size, void* d_ws, size_t ws_size, hipStream_t stream) {
    static int grid = 0;
    if (grid == 0) {
        if (n_in != 22 || in_sizes[0] != SEQ * DM || out_size != SEQ * DM || ws_size < WS_END) { fprintf(stderr, "kernel_launch: unexpected shapes (n_in %d, in0 %d, out %d, ws %zu < %zu)\n", n_in, n_in > 0 ? in_sizes[0] : -1, out_size, ws_size, (size_t)WS_END); grid = -1; return; }
        int dev = 0, cus = 0, per_cu = 0;
        if (hipGetDevice(&dev) != hipSuccess || hipDeviceGetAttribute(&cus, hipDeviceAttributeMultiprocessorCount, dev) != hipSuccess) { grid = -1; return; }
        if (hipFuncSetAttribute((const void*)fwd_megakernel, hipFuncAttributeMaxDynamicSharedMemorySize, LDS_BYTES) != hipSuccess) { fprintf(stderr, "kernel_launch: hipFuncSetAttribute failed\n"); grid = -1; return; }
        if (hipOccupancyMaxActiveBlocksPerMultiprocessor(&per_cu, (const void*)fwd_megakernel, NWAVES * 64, LDS_BYTES) != hipSuccess || per_cu < 1) { fprintf(stderr, "kernel_launch: occupancy query says %d blocks per CU\n", per_cu); grid = -1; (void)hipGetLastError(); return; }
        grid = cus;
    }
    if (grid < 0) return;
    (void)hipMemsetAsync((char*)d_ws + WS_CTL, 0, CTL_ZERO_BYTES, stream);
    Params a{};
    for (int i = 0; i < 22; ++i) a.in[i] = (const float*)d_in[i];
    a.out = (float*)d_out; a.ws = (unsigned char*)d_ws;
    for (int li = 0; li < N_LAUNCHES; ++li) {
        a.ph_lo = (N_LAUNCHES == 1) ? 0 : li; a.ph_hi = (N_LAUNCHES == 1) ? NPHASES : li + 1;
        hipLaunchKernelGGL(fwd_megakernel, dim3(grid), dim3(NWAVES * 64), LDS_BYTES, stream, a);
    }
}
```

```cpp
#include <hip/hip_runtime.h>
#include <cstdio>
#include <cstdint>
namespace pg8 {
#define PG8_LAS __attribute__((address_space(3)))
typedef unsigned short bf16_t;
typedef short bf16x8 __attribute__((ext_vector_type(8)));
typedef float f32x4 __attribute__((ext_vector_type(4)));
typedef unsigned u32x4 __attribute__((ext_vector_type(4)));
constexpr int BM = 256, BK = 64, HALF = 128, HTB = HALF * BK * 2  , STAGE_BYTES = 8 * HTB, NXCD = 8, WGM = 8;

__host__ __device__ __forceinline__ int lds_byte(int r, int c) { const int st = (r >> 4) * 2 + (c >> 5), rr = r & 15, cc = c & 31, ob = rr * 64 + cc * 2; return st * 1024 + (ob ^ (((ob >> 9) & 1) << 5)); }
__host__ __device__ __forceinline__ void stage_rc(int b, int& R, int& C) { const int st = b / 1024, sb = b % 1024, swz = sb ^ (((sb >> 9) & 1) << 5); R = (st >> 1) * 16 + swz / 64; C = (st & 1) * 32 + (swz % 64) / 2; }
__host__ __device__ __forceinline__ int perm32(int rho) { const int n = rho >> 4, i = rho & 15; return 8 * (i >> 2) + 4 * n + (i & 3); }

struct Unit { int pm, pn; };
struct Gemm { const bf16_t* A; const bf16_t* Bt; int M, N, K; size_t b_hstep, b_tstep; };

struct StaticOrder {
    int nM, nN, nwg, G, c;
    __host__ __device__ void init(int M, int N, int G_, int c_) { nM = M / BM; nN = N / BM; nwg = nM * nN; G = G_; c = c_; }
    __host__ __device__ bool next(int i, Unit& u) const {
        const long L = (long)i * G + c; if (L >= nwg) return false;
        int wgid = (int)L; { const int q = nwg / NXCD, r = nwg % NXCD, xcd = wgid % NXCD, off = wgid / NXCD; wgid = (xcd < r ? xcd * (q + 1) : r * (q + 1) + (xcd - r) * q) + off; }
        const int nig = WGM * nN, gid = wgid / nig, fm = gid * WGM, gsz = (nM - fm) < WGM ? (nM - fm) : WGM;
        u.pm = fm + ((wgid % nig) % gsz); u.pn = (wgid % nig) / gsz; return true;
    }
    __device__ __forceinline__ void a_ready(const Unit&) const {}
    __device__ __forceinline__ void done(const Unit&) const {}
};

__device__ __forceinline__ unsigned cvt_pk_bf16(float lo, float hi) { unsigned r; asm volatile("v_cvt_pk_bf16_f32 %0, %1, %2" : "=v"(r) : "v"(lo), "v"(hi)); return r; }
__device__ __forceinline__ float bf_lo(unsigned w) { return __builtin_bit_cast(float, w << 16); }
__device__ __forceinline__ float bf_hi(unsigned w) { return __builtin_bit_cast(float, w & 0xffff0000u); }
__device__ __forceinline__ float sigmoid_f(float z) { return __builtin_amdgcn_rcpf(1.0f + __builtin_amdgcn_exp2f(z * -1.44269504089f)); }
__device__ __forceinline__ float gelu_tanh_f(float x) { const float z = x * (1.5957691216f + 0.0713548163f * x * x); return x * sigmoid_f(z); }

typedef float f32x2 __attribute__((ext_vector_type(2)));
__device__ __forceinline__ f32x2 gelu_pk(f32x2 x) { const f32x2 t = (x * x) * (-0.102943264f) + (-2.302208198f); const f32x2 z = x * t;
    f32x2 e; e.x = __builtin_amdgcn_exp2f(z.x); e.y = __builtin_amdgcn_exp2f(z.y); e = e + 1.0f; f32x2 r; r.x = __builtin_amdgcn_rcpf(e.x); r.y = __builtin_amdgcn_rcpf(e.y); return x * r; }
__device__ __forceinline__ f32x2 sigmoid_pk(f32x2 x) { const f32x2 z = x * (-1.44269504089f);
    f32x2 e; e.x = __builtin_amdgcn_exp2f(z.x); e.y = __builtin_amdgcn_exp2f(z.y); e = e + 1.0f; f32x2 r; r.x = __builtin_amdgcn_rcpf(e.x); r.y = __builtin_amdgcn_rcpf(e.y); return r; }
__device__ __forceinline__ f32x4 gelu_v4(f32x4 v) { const f32x2 a = gelu_pk((f32x2){v[0], v[1]}), b = gelu_pk((f32x2){v[2], v[3]}); return (f32x4){a.x, a.y, b.x, b.y}; }
__device__ __forceinline__ f32x4 sigmoid_v4(f32x4 v) { const f32x2 a = sigmoid_pk((f32x2){v[0], v[1]}), b = sigmoid_pk((f32x2){v[2], v[3]}); return (f32x4){a.x, a.y, b.x, b.y}; }

struct EpiIn {
    static constexpr bool PERM = true, AFTER_DRAIN = false; static constexpr int MIDK = 0;
    bf16_t *U, *V, *P, *GA, *GB; float* stats;
    __device__ __forceinline__ void mid(f32x4 (&)[2][2][4][2], const Unit&, int, int, int, int) const {}
    __device__ __forceinline__ void operator()(const f32x4 (&acc)[2][2][4][2], const Unit& u, int wr, int wc, int fr, int fq) const {
        const int pn = u.pn; bf16_t* base; int ldc, colt, act;
        if (pn < 8) { base = U; ldc = 2048; colt = pn * BM; act = 1; }
        else if (pn < 16) { base = V; ldc = 2048; colt = (pn - 8) * BM; act = 3; }
        else if (pn < 20) { base = P; ldc = 1024; colt = (pn - 16) * BM; act = 0; }
        else if (pn < 28) { base = GA; ldc = 2048; colt = (pn - 20) * BM; act = 2; }
        else { base = GB; ldc = 2048; colt = (pn - 28) * BM; act = 2; }
        const int row0 = u.pm * BM + wr * 64 + fr, col0 = colt + wc * 32 + 8 * fq;
#pragma unroll
        for (int ai = 0; ai < 2; ++ai)
#pragma unroll
            for (int m = 0; m < 4; ++m) { const int row = row0 + ai * HALF + m * 16; bf16_t* rowp = base + (size_t)row * ldc + col0; float s = 0.f, q = 0.f;
#pragma unroll
                for (int bj = 0; bj < 2; ++bj) { f32x4 v0 = acc[ai][bj][m][0], v1 = acc[ai][bj][m][1];
                    if (act == 1 || act == 3) { v0 = gelu_v4(v0); v1 = gelu_v4(v1); }
                    else if (act == 2) { v0 = sigmoid_v4(v0); v1 = sigmoid_v4(v1); }
                    if (act == 3) {
#pragma unroll
                        for (int j = 0; j < 4; ++j) { s += v0[j] + v1[j]; q += v0[j] * v0[j] + v1[j] * v1[j]; } }
                    u32x4 w; w.x = cvt_pk_bf16(v0[0], v0[1]); w.y = cvt_pk_bf16(v0[2], v0[3]); w.z = cvt_pk_bf16(v1[0], v1[1]); w.w = cvt_pk_bf16(v1[2], v1[3]);
                    *(u32x4*)(rowp + bj * HALF) = w; }
                if (act == 3) { s += __shfl_xor(s, 16); s += __shfl_xor(s, 32); q += __shfl_xor(q, 16); q += __shfl_xor(q, 32);
                    if (fq == 0) { atomicAdd(stats + 2 * row, s); atomicAdd(stats + 2 * row + 1, q); } } }
    }
};
struct EpiBf16Plain {
    static constexpr bool PERM = true, AFTER_DRAIN = false; static constexpr int MIDK = 0;
    bf16_t* O; int ldc;
    __device__ __forceinline__ void mid(f32x4 (&)[2][2][4][2], const Unit&, int, int, int, int) const {}
    __device__ __forceinline__ void operator()(const f32x4 (&acc)[2][2][4][2], const Unit& u, int wr, int wc, int fr, int fq) const {
        const int row0 = u.pm * BM + wr * 64 + fr, col0 = u.pn * BM + wc * 32 + 8 * fq;
#pragma unroll
        for (int ai = 0; ai < 2; ++ai)
#pragma unroll
            for (int m = 0; m < 4; ++m) { bf16_t* rowp = O + (size_t)(row0 + ai * HALF + m * 16) * ldc + col0;
#pragma unroll
                for (int bj = 0; bj < 2; ++bj) { const f32x4 v0 = acc[ai][bj][m][0], v1 = acc[ai][bj][m][1];
                    u32x4 w; w.x = cvt_pk_bf16(v0[0], v0[1]); w.y = cvt_pk_bf16(v0[2], v0[3]); w.z = cvt_pk_bf16(v1[0], v1[1]); w.w = cvt_pk_bf16(v1[2], v1[3]);
                    *(u32x4*)(rowp + bj * HALF) = w; } }
    }
};
struct EpiMerge {
    static constexpr bool PERM = true, AFTER_DRAIN = false; static constexpr int MIDK = 32;
    const bf16_t *GA, *GB; bf16_t* O;
    __device__ __forceinline__ void mid(f32x4 (&acc)[2][2][4][2], const Unit& u, int wr, int wc, int fr, int fq) const {
        int row0 = u.pm * BM + wr * 64 + fr; const int col0 = u.pn * BM + wc * 32 + 8 * fq;
        asm volatile("" : "+v"(row0));
#pragma unroll
        for (int ai = 0; ai < 2; ++ai)
#pragma unroll
            for (int m = 0; m < 4; ++m) { const size_t off = (size_t)(row0 + ai * HALF + m * 16) * 2048 + col0;
#pragma unroll
                for (int bj = 0; bj < 2; ++bj) { const u32x4 a = *(const u32x4*)(GA + off + bj * HALF), b = *(const u32x4*)(GB + off + bj * HALF);
                    f32x4 r0, r1;
                    r0[0] = bf_lo(a.x) * __builtin_amdgcn_rcpf(bf_lo(b.x)); r0[1] = bf_hi(a.x) * __builtin_amdgcn_rcpf(bf_hi(b.x));
                    r0[2] = bf_lo(a.y) * __builtin_amdgcn_rcpf(bf_lo(b.y)); r0[3] = bf_hi(a.y) * __builtin_amdgcn_rcpf(bf_hi(b.y));
                    r1[0] = bf_lo(a.z) * __builtin_amdgcn_rcpf(bf_lo(b.z)); r1[1] = bf_hi(a.z) * __builtin_amdgcn_rcpf(bf_hi(b.z));
                    r1[2] = bf_lo(a.w) * __builtin_amdgcn_rcpf(bf_lo(b.w)); r1[3] = bf_hi(a.w) * __builtin_amdgcn_rcpf(bf_hi(b.w));
                    acc[ai][bj][m][0] *= r0; acc[ai][bj][m][1] *= r1; }
                asm volatile("" ::: "memory"); }
    }
    __device__ __forceinline__ void operator()(const f32x4 (&acc)[2][2][4][2], const Unit& u, int wr, int wc, int fr, int fq) const {
        int row0 = u.pm * BM + wr * 64 + fr; const int col0 = u.pn * BM + wc * 32 + 8 * fq;
        asm volatile("" : "+v"(row0));
#pragma unroll
        for (int ai = 0; ai < 2; ++ai)
#pragma unroll
            for (int m = 0; m < 4; ++m) { const size_t off = (size_t)(row0 + ai * HALF + m * 16) * 2048 + col0;
#pragma unroll
                for (int bj = 0; bj < 2; ++bj) { const u32x4 b = *(const u32x4*)(GB + off + bj * HALF); const f32x4 v0 = acc[ai][bj][m][0], v1 = acc[ai][bj][m][1];
                    u32x4 w; w.x = cvt_pk_bf16(v0[0] * bf_lo(b.x), v0[1] * bf_hi(b.x)); w.y = cvt_pk_bf16(v0[2] * bf_lo(b.y), v0[3] * bf_hi(b.y));
                    w.z = cvt_pk_bf16(v1[0] * bf_lo(b.z), v1[1] * bf_hi(b.z)); w.w = cvt_pk_bf16(v1[2] * bf_lo(b.w), v1[3] * bf_hi(b.w));
                    *(u32x4*)(O + off + bj * HALF) = w; }
                asm volatile("" ::: "memory"); }
    }
};
struct EpiF32 {
    static constexpr bool PERM = false, AFTER_DRAIN = false; static constexpr int MIDK = 0;
    float* C; int ldc;
    __device__ __forceinline__ void mid(f32x4 (&)[2][2][4][2], const Unit&, int, int, int, int) const {}
    __device__ __forceinline__ void operator()(const f32x4 (&acc)[2][2][4][2], const Unit& u, int wr, int wc, int fr, int fq) const {
        const int row0 = u.pm * BM + wr * 64 + fr, col0 = u.pn * BM + wc * 32 + 4 * fq;
#pragma unroll
        for (int ai = 0; ai < 2; ++ai)
#pragma unroll
            for (int m = 0; m < 4; ++m) { float* rowp = C + (size_t)(row0 + ai * HALF + m * 16) * ldc + col0;
#pragma unroll
                for (int bj = 0; bj < 2; ++bj)
#pragma unroll
                    for (int n = 0; n < 2; ++n) *(f32x4*)(rowp + bj * HALF + n * 16) = acc[ai][bj][m][n]; }
    }
};

constexpr int UPF = 5632, UPF2 = 11264;
template <int CTRL> __device__ __forceinline__ float dpp_mov(float old, float src) {
    return __builtin_bit_cast(float, __builtin_amdgcn_update_dpp(__builtin_bit_cast(int, old), __builtin_bit_cast(int, src), CTRL, 0xF, 0xF, false)); }
struct EpiUpConv {
    static constexpr bool PERM = true, AFTER_DRAIN = false; static constexpr int MIDK = 0;
    bf16_t* ACT; float* RAWB; const float* cw; const float* cb; PG8_LAS unsigned char* xch;
    __device__ __forceinline__ void mid(f32x4 (&)[2][2][4][2], const Unit&, int, int, int, int) const {}
    __device__ __forceinline__ void operator()(const f32x4 (&acc)[2][2][4][2], const Unit& u, int wr, int wc, int fr, int fq) const {
        const int colh = 32 * wc + 8 * fq; int ca = u.pn * HALF + colh;
        asm volatile("" : "+v"(ca));
        PG8_LAS float* X = (PG8_LAS float*)xch;
#pragma unroll
        for (int ai = 0; ai < 2; ++ai) { const int s = 2 * ai + wr;
            if (fr >= 14) {
                if (s < 3) {
#pragma unroll
                    for (int bj = 0; bj < 2; ++bj)
#pragma unroll
                        for (int n = 0; n < 2; ++n) *(PG8_LAS f32x4*)(X + ((s * 2 + (fr - 14)) * 256 + bj * HALF + colh + 4 * n)) = acc[ai][bj][3][n];
                } else {
#pragma unroll
                    for (int bj = 0; bj < 2; ++bj)
#pragma unroll
                        for (int n = 0; n < 2; ++n) *(f32x4*)(RAWB + ((size_t)(u.pm * 4 + 2 + (fr - 14)) * UPF2 + bj * UPF + ca + 4 * n)) = acc[ai][bj][3][n];
                } } }
        if (wr == 0 && fr < 2) {
#pragma unroll
            for (int bj = 0; bj < 2; ++bj)
#pragma unroll
                for (int n = 0; n < 2; ++n) *(f32x4*)(RAWB + ((size_t)(u.pm * 4 + fr) * UPF2 + bj * UPF + ca + 4 * n)) = acc[0][bj][0][n]; }
        asm volatile("s_waitcnt lgkmcnt(0)" ::: "memory"); __builtin_amdgcn_s_barrier(); asm volatile("" ::: "memory");
        f32x4 w0[2][2], w1[2][2], w2[2][2], bb[2][2];
#pragma unroll
        for (int bj = 0; bj < 2; ++bj)
#pragma unroll
            for (int n = 0; n < 2; ++n) { const float* pc = cw + bj * UPF + ca + 4 * n; w0[bj][n] = *(const f32x4*)pc; w1[bj][n] = *(const f32x4*)(pc + UPF2); w2[bj][n] = *(const f32x4*)(pc + 2 * UPF2);
                bb[bj][n] = *(const f32x4*)(cb + bj * UPF + ca + 4 * n); }
#pragma unroll
        for (int ai = 0; ai < 2; ++ai) {
            f32x4 pv[2][2]; const int sp = 2 * ai + wr - 1;
#pragma unroll
            for (int bj = 0; bj < 2; ++bj)
#pragma unroll
                for (int n = 0; n < 2; ++n) pv[bj][n] = (sp >= 0) ? *(const PG8_LAS f32x4*)(X + ((sp * 2 + (fr & 1)) * 256 + bj * HALF + colh + 4 * n)) : (f32x4){0.f, 0.f, 0.f, 0.f};
#pragma unroll
            for (int m = 0; m < 4; ++m) {
                f32x4 cv[2][2];
#pragma unroll
                for (int bj = 0; bj < 2; ++bj)
#pragma unroll
                    for (int n = 0; n < 2; ++n) { const f32x4 v = acc[ai][bj][m][n]; const f32x4 pp = (m == 0) ? pv[bj][n] : acc[ai][bj][m > 0 ? m - 1 : 0][n]; f32x4 p1, p2;
#pragma unroll
                        for (int j = 0; j < 4; ++j) { p1[j] = dpp_mov<0x111>(dpp_mov<0x121>(pp[j], pp[j]), v[j]); p2[j] = dpp_mov<0x112>(dpp_mov<0x122>(pp[j], pp[j]), v[j]); }
                        cv[bj][n] = bb[bj][n] + w0[bj][n] * p2 + w1[bj][n] * p1 + w2[bj][n] * v; }
                const f32x4 o0 = gelu_v4(cv[0][0]) * cv[1][0], o1 = gelu_v4(cv[0][1]) * cv[1][1];
                u32x4 w; w.x = cvt_pk_bf16(o0[0], o0[1]); w.y = cvt_pk_bf16(o0[2], o0[3]); w.z = cvt_pk_bf16(o1[0], o1[1]); w.w = cvt_pk_bf16(o1[2], o1[3]);
                const int row = u.pm * BM + ai * HALF + wr * 64 + m * 16 + fr;
                if (!(ai == 0 && m == 0 && wr == 0 && fr < 2)) *(u32x4*)(ACT + (size_t)row * UPF + ca) = w;
            }
        }
    }
};
struct FixOrder : StaticOrder {
    bf16_t* ACT; const float* RAWB; const float* cw; const float* cb;
    __device__ __forceinline__ void a_ready(const Unit& u) const {
        for (int ch = threadIdx.x; ch < 2 * (UPF / 8); ch += 512) { const int r = ch / (UPF / 8), q8 = (ch % (UPF / 8)) * 8;
            f32x4 a0 = *(const f32x4*)(cb + q8), a1 = *(const f32x4*)(cb + q8 + 4), g0 = *(const f32x4*)(cb + UPF + q8), g1 = *(const f32x4*)(cb + UPF + q8 + 4);
#pragma unroll
            for (int k = 0; k < 3; ++k) { const int rr = r - 2 + k;
                if (rr >= 0 || u.pm > 0) { const float* src = RAWB + (size_t)(rr >= 0 ? u.pm * 4 + rr : (u.pm - 1) * 4 + 4 + rr) * UPF2; const float* wk = cw + k * UPF2;
                    a0 += *(const f32x4*)(wk + q8) * *(const f32x4*)(src + q8); a1 += *(const f32x4*)(wk + q8 + 4) * *(const f32x4*)(src + q8 + 4);
                    g0 += *(const f32x4*)(wk + UPF + q8) * *(const f32x4*)(src + UPF + q8); g1 += *(const f32x4*)(wk + UPF + q8 + 4) * *(const f32x4*)(src + UPF + q8 + 4); } }
            u32x4 w; w.x = cvt_pk_bf16(gelu_tanh_f(a0[0]) * g0[0], gelu_tanh_f(a0[1]) * g0[1]); w.y = cvt_pk_bf16(gelu_tanh_f(a0[2]) * g0[2], gelu_tanh_f(a0[3]) * g0[3]);
            w.z = cvt_pk_bf16(gelu_tanh_f(a1[0]) * g1[0], gelu_tanh_f(a1[1]) * g1[1]); w.w = cvt_pk_bf16(gelu_tanh_f(a1[2]) * g1[2], gelu_tanh_f(a1[3]) * g1[3]);
            *(u32x4*)(ACT + (size_t)(u.pm * BM + r) * UPF + q8) = w; }
        asm volatile("s_waitcnt vmcnt(0)" ::: "memory"); __builtin_amdgcn_s_barrier(); asm volatile("" ::: "memory");
    }
};

struct PanelSS {
    unsigned* xbuf;
    unsigned* cnt;
    unsigned* tmo;
    float eps;
    template <class Pre>
    __device__ __forceinline__ void run(const f32x4 (&v)[2][2][4][2], const Unit& u, int wr, int wc, int fr, int fq, PG8_LAS unsigned char* lds, int wid, int lane, const Pre& pre) const {
        PG8_LAS float* P = (PG8_LAS float*)lds;
        PG8_LAS float* S = (PG8_LAS float*)(lds + 8192);
#pragma unroll
        for (int ai = 0; ai < 2; ++ai)
#pragma unroll
            for (int m = 0; m < 4; ++m) { float q = 0.f;
#pragma unroll
                for (int bj = 0; bj < 2; ++bj)
#pragma unroll
                    for (int n = 0; n < 2; ++n) { const f32x4 x = v[ai][bj][m][n]; q += (x[0] * x[0] + x[1] * x[1]) + (x[2] * x[2] + x[3] * x[3]); }
                q += __shfl_xor(q, 16); q += __shfl_xor(q, 32);
                if (fq == 0) P[(ai * HALF + wr * 64 + m * 16 + fr) * 4 + wc] = q; }
        asm volatile("s_waitcnt lgkmcnt(0)" ::: "memory"); __builtin_amdgcn_s_barrier(); asm volatile("" ::: "memory");
        const int row = wid * 32 + (lane & 31);
        if (lane < 32) { const float q = (P[row * 4 + 0] + P[row * 4 + 1]) + (P[row * 4 + 2] + P[row * 4 + 3]);
            __hip_atomic_store(xbuf + ((size_t)(u.pm * BM + row) * 8 + u.pn), __builtin_bit_cast(unsigned, q), __ATOMIC_RELAXED, __HIP_MEMORY_SCOPE_AGENT); }
        asm volatile("s_waitcnt vmcnt(0)" ::: "memory");
        if (lane == 0) __hip_atomic_fetch_add(cnt + 64 * u.pm, 1u, __ATOMIC_RELAXED, __HIP_MEMORY_SCOPE_AGENT);
        asm volatile("" ::: "memory");
        if (wid != 0) pre();
        if (wid == 0) {
            unsigned sp = 0;
            while ((unsigned)__builtin_amdgcn_readfirstlane(__hip_atomic_load(cnt + 64 * u.pm, __ATOMIC_RELAXED, __HIP_MEMORY_SCOPE_AGENT)) < 64u) {
                __builtin_amdgcn_s_sleep(2);
                if (++sp > (1u << 20)) { if (lane == 0) __hip_atomic_store(tmo, 1u, __ATOMIC_RELAXED, __HIP_MEMORY_SCOPE_AGENT); break; } }
            __builtin_amdgcn_fence(__ATOMIC_ACQUIRE, "agent");
            asm volatile("s_waitcnt vmcnt(0)" ::: "memory");
            float q[4];
#pragma unroll
            for (int r = 0; r < 4; ++r) { const unsigned* slot = xbuf + (size_t)(u.pm * BM + lane + 64 * r) * 8; float a = 0.f;
#pragma unroll
                for (int t = 0; t < 8; ++t) a += __builtin_bit_cast(float, __hip_atomic_load(slot + t, __ATOMIC_RELAXED, __HIP_MEMORY_SCOPE_AGENT));
                q[r] = a; }
            asm volatile("" ::: "memory");
            pre();
            asm volatile("" ::: "memory");
#pragma unroll
            for (int r = 0; r < 4; ++r) S[lane + 64 * r] = 1.0f / sqrtf(q[r] * (1.0f / 2048.0f) + eps);
        }
        asm volatile("s_waitcnt lgkmcnt(0)" ::: "memory"); __builtin_amdgcn_s_barrier(); asm volatile("" ::: "memory");
    }
};
struct NoPre { __device__ __forceinline__ void operator()() const {} };
struct EpiMixFused {
    static constexpr bool PERM = true, AFTER_DRAIN = true; static constexpr int MIDK = 0;
    const float* x; bf16_t* X1B; bf16_t* H2; const float* vec; PanelSS st1, st2;
    __device__ __forceinline__ void mid(f32x4 (&)[2][2][4][2], const Unit&, int, int, int, int) const {}
    __device__ __forceinline__ void operator()(const f32x4 (&)[2][2][4][2], const Unit&, int, int, int, int) const {}
    __device__ __forceinline__ void fused(f32x4 (&acc)[2][2][4][2], const Unit& u, int wr, int wc, int fr, int fq, PG8_LAS unsigned char* lds, int wid, int lane) const {
        const PG8_LAS float* S = (const PG8_LAS float*)(lds + 8192);
        const int col0 = u.pn * BM + wc * 32 + 8 * fq;
        st1.run(acc, u, wr, wc, fr, fq, lds, wid, lane, NoPre{});
        { f32x4 g1[2][2];
#pragma unroll
          for (int bj = 0; bj < 2; ++bj)
#pragma unroll
            for (int n = 0; n < 2; ++n) g1[bj][n] = *(const f32x4*)(vec + col0 + bj * HALF + n * 4);
#pragma unroll
          for (int ai = 0; ai < 2; ++ai)
#pragma unroll
            for (int m = 0; m < 4; ++m) { const int r = ai * HALF + wr * 64 + m * 16 + fr; const float rs = S[r]; const size_t off = (size_t)(u.pm * BM + r) * 2048 + col0;
#pragma unroll
                for (int bj = 0; bj < 2; ++bj) { const f32x4 xa = __builtin_nontemporal_load((const f32x4*)(x + off + bj * HALF)), xb = __builtin_nontemporal_load((const f32x4*)(x + off + bj * HALF + 4));
                    const f32x4 x1a = xa + g1[bj][0] * (acc[ai][bj][m][0] * rs), x1b = xb + g1[bj][1] * (acc[ai][bj][m][1] * rs);
                    acc[ai][bj][m][0] = x1a; acc[ai][bj][m][1] = x1b;
                    u32x4 o; o.x = cvt_pk_bf16(x1a[0], x1a[1]); o.y = cvt_pk_bf16(x1a[2], x1a[3]); o.z = cvt_pk_bf16(x1b[0], x1b[1]); o.w = cvt_pk_bf16(x1b[2], x1b[3]);
                    *(u32x4*)(X1B + off + bj * HALF) = o; }
                asm volatile("" ::: "memory"); } }
        st2.run(acc, u, wr, wc, fr, fq, lds, wid, lane, NoPre{});
        { f32x4 a2[2][2], b2[2][2];
#pragma unroll
          for (int bj = 0; bj < 2; ++bj)
#pragma unroll
            for (int n = 0; n < 2; ++n) { a2[bj][n] = *(const f32x4*)(vec + 2048 + col0 + bj * HALF + n * 4); b2[bj][n] = *(const f32x4*)(vec + 4096 + col0 + bj * HALF + n * 4); }
#pragma unroll
          for (int ai = 0; ai < 2; ++ai)
#pragma unroll
            for (int m = 0; m < 4; ++m) { const int r = ai * HALF + wr * 64 + m * 16 + fr; const float rs = S[r]; const size_t off = (size_t)(u.pm * BM + r) * 2048 + col0;
#pragma unroll
                for (int bj = 0; bj < 2; ++bj) { const f32x4 ha = acc[ai][bj][m][0] * rs * a2[bj][0] + b2[bj][0], hb = acc[ai][bj][m][1] * rs * a2[bj][1] + b2[bj][1];
                    u32x4 o; o.x = cvt_pk_bf16(ha[0], ha[1]); o.y = cvt_pk_bf16(ha[2], ha[3]); o.z = cvt_pk_bf16(hb[0], hb[1]); o.w = cvt_pk_bf16(hb[2], hb[3]);
                    *(u32x4*)(H2 + off + bj * HALF) = o; } } }
    }
};
struct EpiOutFused {
    static constexpr bool PERM = true, AFTER_DRAIN = true; static constexpr int MIDK = 0;
    const bf16_t* X1B; float* out; const float* vec; PanelSS st;
    __device__ __forceinline__ void mid(f32x4 (&)[2][2][4][2], const Unit&, int, int, int, int) const {}
    __device__ __forceinline__ void operator()(const f32x4 (&)[2][2][4][2], const Unit&, int, int, int, int) const {}
    struct PreX1B { u32x4 (&xb)[2][4][2]; const bf16_t* src;
        __device__ __forceinline__ void operator()() const {
#pragma unroll
            for (int ai = 0; ai < 2; ++ai)
#pragma unroll
                for (int m = 0; m < 4; ++m)
#pragma unroll
                    for (int bj = 0; bj < 2; ++bj) xb[ai][m][bj] = __builtin_nontemporal_load((const u32x4*)(src + (size_t)(ai * HALF + m * 16) * 2048 + bj * HALF)); } };
    __device__ __forceinline__ void fused(f32x4 (&acc)[2][2][4][2], const Unit& u, int wr, int wc, int fr, int fq, PG8_LAS unsigned char* lds, int wid, int lane) const {
        const PG8_LAS float* S = (const PG8_LAS float*)(lds + 8192);
        const int col0 = u.pn * BM + wc * 32 + 8 * fq;
        u32x4 xb[2][4][2];
        st.run(acc, u, wr, wc, fr, fq, lds, wid, lane, PreX1B{xb, X1B + (size_t)(u.pm * BM + wr * 64 + fr) * 2048 + col0});
        f32x4 g2[2][2];
#pragma unroll
        for (int bj = 0; bj < 2; ++bj)
#pragma unroll
            for (int n = 0; n < 2; ++n) g2[bj][n] = *(const f32x4*)(vec + 3 * 2048 + col0 + bj * HALF + n * 4);
#pragma unroll
        for (int ai = 0; ai < 2; ++ai)
#pragma unroll
            for (int m = 0; m < 4; ++m) { const int r = ai * HALF + wr * 64 + m * 16 + fr; const float rs = S[r]; const size_t off = (size_t)(u.pm * BM + r) * 2048 + col0;
#pragma unroll
                for (int bj = 0; bj < 2; ++bj) { const u32x4 xw = xb[ai][m][bj];
                    const f32x4 xa = (f32x4){bf_lo(xw.x), bf_hi(xw.x), bf_lo(xw.y), bf_hi(xw.y)}, xc = (f32x4){bf_lo(xw.z), bf_hi(xw.z), bf_lo(xw.w), bf_hi(xw.w)};
                    __builtin_nontemporal_store(xa + g2[bj][0] * (acc[ai][bj][m][0] * rs), (f32x4*)(out + off + bj * HALF)); __builtin_nontemporal_store(xc + g2[bj][1] * (acc[ai][bj][m][1] * rs), (f32x4*)(out + off + bj * HALF + 4)); }
                asm volatile("" ::: "memory"); }
    }
};

template <class Epi, class Sched, bool ALIGN_EPI = false, bool SP2 = false, int EPI_S = 0>
__device__ __forceinline__ void gemm_phase(PG8_LAS unsigned char* lds, const Gemm g, const Sched& S, const Epi& E) {
    const int tid = threadIdx.x, wid = __builtin_amdgcn_readfirstlane(tid >> 6), lane = tid & 63, wr = wid >> 2, wc = wid & 3, fr = lane & 15, fq = lane >> 4;
    const int K = g.K, nt = K / BK;
    unsigned voffA[2], voffB[2];
#pragma unroll
    for (int i = 0; i < 2; ++i) { int R, C; stage_rc(tid * 16 + i * 8192, R, C); const int Rb = Epi::PERM ? ((R & ~31) + perm32(R & 31)) : R;
        voffA[i] = (unsigned)(R * K + C) * 2u; voffB[i] = (unsigned)(Rb * K + C) * 2u; }
    const size_t kstep = (size_t)(BK * 2);
    const size_t hstep = (size_t)HALF * K * 2;
    const size_t tstep = 2 * hstep;
    const size_t hstepB = g.b_hstep ? g.b_hstep : hstep, tstepB = g.b_tstep ? g.b_tstep : tstep;
    const unsigned ldsw = (unsigned)wid * 1024u;
    const int aoff = lds_byte(wr * 64 + fr, fq * 8), boff = lds_byte(wc * 32 + fr, fq * 8);
#define PG8_SA(b, h) (((b) * 2 + (h)) * HTB)
#define PG8_SB(b, h) ((4 + (b) * 2 + (h)) * HTB)
#define PG8_STAGE(bufoff, gbase, voff) do { _Pragma("unroll") for (int _i = 0; _i < 2; ++_i) \
        __builtin_amdgcn_raw_ptr_buffer_load_lds((&(voff)[0] == &voffA[0]) ? rsA : rsB, (PG8_LAS void*)(lds + (bufoff) + ldsw + _i * 8192), 16, (int)(voff)[_i], (int)(gbase), 0, 0); } while (0)
#define PG8_LDA(dst, b, h) do { _Pragma("unroll") for (int m = 0; m < 4; ++m) _Pragma("unroll") for (int k = 0; k < 2; ++k) dst[m][k] = *(const PG8_LAS bf16x8*)(lds + PG8_SA(b, h) + aoff + m * 2048 + k * 1024); } while (0)
#define PG8_LDB(dst, b, h) do { _Pragma("unroll") for (int n = 0; n < 2; ++n) _Pragma("unroll") for (int k = 0; k < 2; ++k) dst[n][k] = *(const PG8_LAS bf16x8*)(lds + PG8_SB(b, h) + boff + n * 2048 + k * 1024); } while (0)
#define PG8_MMA(ai, bj, At, Bt) do { __builtin_amdgcn_s_setprio(1); _Pragma("unroll") for (int m = 0; m < 4; ++m) _Pragma("unroll") for (int n = 0; n < 2; ++n) _Pragma("unroll") for (int k = 0; k < 2; ++k) \
        acc[ai][bj][m][n] = __builtin_amdgcn_mfma_f32_16x16x32_bf16(Bt[n][k], At[m][k], acc[ai][bj][m][n], 0, 0, 0); __builtin_amdgcn_s_setprio(0); } while (0)
#define PG8_WAIT_V(n) asm volatile("s_waitcnt vmcnt(" #n ")" ::: "memory")
#define PG8_WAIT_VN(n) asm volatile("s_waitcnt vmcnt(%0)" :: "i"(n) : "memory")
#define PG8_WAIT_L(n) asm volatile("s_waitcnt lgkmcnt(" #n ")" ::: "memory")
#define PG8_BAR __builtin_amdgcn_s_barrier()
#define PG8_SCHED __builtin_amdgcn_sched_barrier(0)
    Unit cur, nxt; int ui = 0;
    [[maybe_unused]] bool fa = false;
    if (!S.next(0, cur)) return;
    f32x4 acc[2][2][4][2];
#pragma unroll
    for (int a = 0; a < 2; ++a)
#pragma unroll
        for (int b = 0; b < 2; ++b)
#pragma unroll
            for (int m = 0; m < 4; ++m)
#pragma unroll
                for (int n = 0; n < 2; ++n) acc[a][b][m][n] = (f32x4){0.f, 0.f, 0.f, 0.f};
    bf16x8 At[4][2], B0[2][2], B1[2][2];
    const __amdgpu_buffer_rsrc_t rsA = __builtin_amdgcn_make_buffer_rsrc((void*)g.A, 0, (int)((size_t)g.M * K * 2), 0x00020000), rsB = __builtin_amdgcn_make_buffer_rsrc((void*)g.Bt, 0, (int)((size_t)g.N * K * 2), 0x00020000);
    unsigned cA = (unsigned)((size_t)cur.pm * tstep), cB = (unsigned)((size_t)cur.pn * tstepB);
    S.a_ready(cur);
    if constexpr (SP2) {
        PG8_STAGE(PG8_SB(0, 0), cB, voffB); PG8_STAGE(PG8_SB(0, 1), cB + hstepB, voffB); PG8_STAGE(PG8_SA(0, 0), cA, voffA); PG8_STAGE(PG8_SA(0, 1), cA + hstep, voffA);
        if (wr == 1) PG8_BAR;
        PG8_WAIT_V(2); PG8_BAR;
        PG8_STAGE(PG8_SB(1, 0), cB + kstep, voffB); PG8_STAGE(PG8_SB(1, 1), cB + hstepB + kstep, voffB);
        PG8_WAIT_V(6); PG8_BAR;
    } else {
        PG8_STAGE(PG8_SB(0, 0), cB, voffB); PG8_STAGE(PG8_SA(0, 0), cA, voffA); PG8_STAGE(PG8_SB(0, 1), cB + hstepB, voffB); PG8_STAGE(PG8_SA(0, 1), cA + hstep, voffA);
        if (wr == 1) PG8_BAR;
        PG8_WAIT_V(4); PG8_BAR;
        PG8_STAGE(PG8_SB(1, 0), cB + kstep, voffB); PG8_STAGE(PG8_SA(1, 0), cA + kstep, voffA); PG8_STAGE(PG8_SB(1, 1), cB + hstepB + kstep, voffB);
        PG8_WAIT_V(6); PG8_BAR;
    }
    for (;;) {
        const bool has_next = S.next(ui + 1, nxt);
        const unsigned nA = has_next ? (unsigned)((size_t)nxt.pm * tstep) : cA, nB = has_next ? (unsigned)((size_t)nxt.pn * tstepB) : cB;
        for (int tb = 0; tb < nt; ) {
        const int te = (Epi::MIDK > 0 && tb < Epi::MIDK) ? Epi::MIDK : nt;
        if constexpr (Epi::MIDK > 0) { if (tb == Epi::MIDK) E.mid(acc, cur, wr, wc, fr, fq); }
#define PG8_KBODY(V1, V2, V3, DO_A1) { \
            const bool last = (t == nt - 2); \
            const unsigned a1 = cA + (unsigned)((t + 1) * kstep); \
            const unsigned a2 = last ? nA : cA + (unsigned)((t + 2) * kstep), b2 = last ? nB : cB + (unsigned)((t + 2) * kstep); \
            const unsigned b3 = b2 + (unsigned)kstep; \
            if (last && has_next) S.a_ready(nxt); \
              \
            PG8_LDB(B0, 0, 0); PG8_LDB(B1, 0, 1); PG8_SCHED; PG8_LDA(At, 0, 0); if (DO_A1) { PG8_STAGE(PG8_SA(1, 0), a1, voffA); PG8_STAGE(PG8_SA(1, 1), a1 + hstep, voffA); } \
            PG8_WAIT_VN(V1); PG8_WAIT_L(0); PG8_BAR; PG8_MMA(0, 0, At, B0); PG8_MMA(0, 1, At, B1); PG8_BAR; PG8_SCHED; \
              \
            PG8_LDA(At, 0, 1); PG8_STAGE(PG8_SB(0, 0), b2, voffB); PG8_STAGE(PG8_SB(0, 1), b2 + hstepB, voffB); \
            PG8_WAIT_VN(V2); PG8_WAIT_L(0); PG8_BAR; PG8_MMA(1, 0, At, B0); PG8_MMA(1, 1, At, B1); PG8_BAR; PG8_SCHED; \
              \
            PG8_LDB(B0, 1, 0); PG8_LDB(B1, 1, 1); PG8_SCHED; PG8_LDA(At, 1, 0); PG8_STAGE(PG8_SA(0, 0), a2, voffA); PG8_STAGE(PG8_SA(0, 1), a2 + hstep, voffA); \
            PG8_WAIT_VN(V3); PG8_WAIT_L(0); PG8_BAR; PG8_MMA(0, 0, At, B0); PG8_MMA(0, 1, At, B1); PG8_BAR; PG8_SCHED; \
              \
            PG8_LDA(At, 1, 1); PG8_STAGE(PG8_SB(1, 0), b3, voffB); PG8_STAGE(PG8_SB(1, 1), b3 + hstepB, voffB); \
            PG8_WAIT_VN(6); PG8_WAIT_L(0); PG8_BAR; PG8_MMA(1, 0, At, B0); PG8_MMA(1, 1, At, B1); PG8_BAR; PG8_SCHED; }
        static_assert(SP2, "this body keeps only the two-super-phase K-loop");
        int t = tb;
        if constexpr (EPI_S > 0) { if (fa && t == 0 && te >= 2) { PG8_KBODY(8 + EPI_S, 6 + EPI_S, 8 + EPI_S, false); t = 2; } }
        for (; t < te; t += 2) PG8_KBODY(8, 6, 8, true);
        tb = te; }
        if constexpr (ALIGN_EPI) { if (wr == 0) PG8_BAR; }
        if constexpr (EPI_S > 0 && ALIGN_EPI) { fa = has_next; if (has_next) { PG8_STAGE(PG8_SA(1, 0), nA + kstep, voffA); PG8_STAGE(PG8_SA(1, 1), nA + kstep + hstep, voffA); PG8_WAIT_VN(4); } }
        if constexpr (!Epi::AFTER_DRAIN) { E(acc, cur, wr, wc, fr, fq); S.done(cur); }
        if (!has_next) break;
#pragma unroll
        for (int a = 0; a < 2; ++a)
#pragma unroll
            for (int b = 0; b < 2; ++b)
#pragma unroll
                for (int m = 0; m < 4; ++m)
#pragma unroll
                    for (int n = 0; n < 2; ++n) acc[a][b][m][n] = (f32x4){0.f, 0.f, 0.f, 0.f};
        cur = nxt; cA = nA; cB = nB; ++ui;
        if constexpr (ALIGN_EPI) { if (wr == 1) PG8_BAR; }
    }
    PG8_WAIT_V(0);
    if constexpr (!ALIGN_EPI) { if (wr == 0) PG8_BAR; }
    PG8_BAR;
    if constexpr (Epi::AFTER_DRAIN) { E.fused(acc, cur, wr, wc, fr, fq, lds, wid, lane); S.done(cur); }
#undef PG8_SA
#undef PG8_SB
#undef PG8_STAGE
#undef PG8_LDA
#undef PG8_LDB
#undef PG8_MMA
#undef PG8_WAIT_VN
#undef PG8_KBODY
#undef PG8_WAIT_V
#undef PG8_WAIT_L
#undef PG8_BAR
#undef PG8_SCHED
}
}
#define GAS __attribute__((address_space(1)))
#define LAS __attribute__((address_space(3)))
typedef unsigned short bf16;
typedef unsigned v4u __attribute__((ext_vector_type(4)));
typedef float f32x4 __attribute__((ext_vector_type(4)));
typedef short bf16x8 __attribute__((ext_vector_type(8)));
typedef GAS unsigned gu32;
typedef GAS unsigned long long gu64;
#define RLX_AGENT __ATOMIC_RELAXED, __HIP_MEMORY_SCOPE_AGENT
#define LDS_WAIT() asm volatile("s_waitcnt lgkmcnt(0)" ::: "memory")
#define VM_WAIT() asm volatile("s_waitcnt vmcnt(0)" ::: "memory")
__device__ __forceinline__ unsigned long long rt() { return __builtin_amdgcn_s_memrealtime(); }
__device__ __forceinline__ unsigned f2bf(float f) { unsigned u = __builtin_bit_cast(unsigned, f); return (u + 0x7fffu + ((u >> 16) & 1u)) >> 16; }
__device__ __forceinline__ unsigned pk2(float lo, float hi) { return f2bf(lo) | (f2bf(hi) << 16); }

#define XB_TMO      128
#define XB_XCNT(j)  (256  + 64 * (j))
#define XB_XSUB(j)  (1280 + 64 * (j))
#define XB_XGEN(j)  (2304 + 64 * (j))
#define XB_TOP      3328
#define XB_TOPGEN   3392
#define XCD_BAR_WORDS 3456
#define XB_SPIN_CAP (1u << 18)

__device__ __forceinline__ unsigned xb_ld(unsigned* p)              { return __hip_atomic_load(p, __ATOMIC_RELAXED, __HIP_MEMORY_SCOPE_AGENT); }
__device__ __forceinline__ unsigned xb_add(unsigned* p, unsigned v) { return __hip_atomic_fetch_add(p, v, __ATOMIC_RELAXED, __HIP_MEMORY_SCOPE_AGENT); }
__device__ __forceinline__ unsigned xb_xcc_id() { return (unsigned)__builtin_amdgcn_s_getreg((3 << 11) | 20) & 0xFu; }
#define XB_SPIN(cond, bar) do { unsigned _sp = 0; while (cond) { __builtin_amdgcn_s_sleep(1); \
    if ((++_sp & 255u) == 0u) { if (xb_ld(&(bar)[XB_TMO])) break; if (_sp > XB_SPIN_CAP) { atomicAdd(&(bar)[XB_TMO], 1u); break; } } } } while (0)

struct XcdBarrier {
    unsigned* bar; unsigned x;
    volatile LAS unsigned* st;
};

__device__ __forceinline__ XcdBarrier xcd_barrier_post(unsigned* bar, volatile LAS unsigned* st) {
    XcdBarrier b; b.bar = bar; b.x = xb_xcc_id(); b.st = st;
    if (threadIdx.x == 0) (void)xb_add(&bar[XB_XCNT(b.x)], 1u);
    return b;
}
__device__ __forceinline__ void xcd_barrier_complete(unsigned* bar, unsigned x, unsigned& nloc, unsigned& nx) {
    const unsigned G = gridDim.x * gridDim.y * gridDim.z;
    unsigned sum, cnt, mine, sp = 0u;
    for (;;) {
        sum = 0u; cnt = 0u; mine = 0u;
#pragma unroll
        for (unsigned j = 0; j < 16; ++j) { const unsigned c = xb_ld(&bar[XB_XCNT(j)]); sum += c; cnt += (c > 0u) ? 1u : 0u; mine = (j == x) ? c : mine; }
        if (sum == G) break;
        __builtin_amdgcn_s_sleep(1);
        if ((++sp & 255u) == 0u) { if (xb_ld(&bar[XB_TMO])) break; if (sp > XB_SPIN_CAP) { atomicAdd(&bar[XB_TMO], 1u); break; } }
    }
    nloc = mine > 0u ? mine : 1u; nx = cnt > 0u ? cnt : 1u;
}

__device__ __forceinline__ void xcd_barrier(const XcdBarrier& b) {
    asm volatile("s_waitcnt vmcnt(0)" ::: "memory");
    __syncthreads();
    if (threadIdx.x == 0) {
        unsigned* bar = b.bar;
        __builtin_amdgcn_s_waitcnt(0);
        unsigned nloc = b.st[0], nx = b.st[1];
        if (nloc == 0u) { xcd_barrier_complete(bar, b.x, nloc, nx); b.st[0] = nloc; b.st[1] = nx; }
        const unsigned old = xb_add(&bar[XB_XSUB(b.x)], 1u);
        const unsigned gen = old / nloc;
        if (old + 1u == (gen + 1u) * nloc) {
            __builtin_amdgcn_fence(__ATOMIC_RELEASE, "agent");
            asm volatile("s_waitcnt vmcnt(0)" ::: "memory");
            const unsigned og = xb_add(&bar[XB_TOP], 1u);
            const unsigned tg = og / nx;
            if (og + 1u == (tg + 1u) * nx) xb_add(&bar[XB_TOPGEN], 1u);
            else XB_SPIN(xb_ld(&bar[XB_TOPGEN]) == tg, bar);
            __builtin_amdgcn_fence(__ATOMIC_ACQUIRE, "agent");
            xb_add(&bar[XB_XGEN(b.x)], 1u);
            asm volatile("s_waitcnt vmcnt(0)" ::: "memory");
        } else {
            XB_SPIN(xb_ld(&bar[XB_XGEN(b.x)]) == gen, bar);
            __builtin_amdgcn_fence(__ATOMIC_ACQUIRE, "agent");
            asm volatile("s_waitcnt vmcnt(0)" ::: "memory");
        }
    }
    __syncthreads();
}

#ifndef MK_N_LAUNCHES
#define MK_N_LAUNCHES 1
#endif
constexpr int NWAVES = 8, NPHASES = 10;
constexpr int N_LAUNCHES = MK_N_LAUNCHES;
constexpr int SEQ = 8192, DM = 2048, AW = 2048, BW = 1024, INC = 9216, FF = 5632, FF2 = 11264, NMOD = 12288, KAB = 3072;
constexpr float EPS = 1e-6f;
constexpr size_t MiB = 1u << 20;
constexpr size_t WS_CTL = 0, CTL_ZERO_BYTES = 1 * MiB;
constexpr size_t WS_MOD = 64 * 1024, WS_STATS = 128 * 1024;
constexpr size_t WS_CNT = 192 * 1024;
constexpr size_t WS_XBUF = 1 * MiB + 128 * 1024;
constexpr size_t WS_VEC = 1 * MiB;
constexpr size_t WS_WIN = 2 * MiB, WS_WAB = 38 * MiB, WS_WOUT = 50 * MiB, WS_WUP = 58 * MiB, WS_WDN = 102 * MiB, WS_WPOOL = 124 * MiB, WS_WSP = WS_WPOOL + 512 * 1024;
constexpr size_t WS_H1 = 125 * MiB, WS_U = 157 * MiB, WS_V = 189 * MiB, WS_P = 221 * MiB, WS_GA = 237 * MiB, WS_GB = 269 * MiB;
constexpr size_t WS_SGPB = 301 * MiB, WS_MERGED = 349 * MiB, WS_MIX = 125 * MiB, WS_H2 = 301 * MiB, WS_ACT = 125 * MiB, WS_Y = 213 * MiB;
constexpr size_t WS_RAWB = 389 * MiB;
constexpr size_t WS_END = 395 * MiB;
constexpr int CW_BAR = 4096;
static_assert((CW_BAR + XCD_BAR_WORDS) * 4 <= (int)WS_MOD && WS_MOD + NMOD * 4 <= WS_STATS && WS_STATS + SEQ * 8 <= WS_CNT && WS_CNT + 3 * 32 * 256 <= CTL_ZERO_BYTES && WS_XBUF + 3 * 256 * 1024 <= 2 * MiB, "CTL map");
constexpr int RING_OFF = 0, RING_BYTES = 131072, LDSCTL_OFF = RING_BYTES, MISC_OFF = LDSCTL_OFF + 320, XCH_OFF = RING_BYTES + 1024, LDS_BYTES = 147456;

typedef unsigned v2u __attribute__((ext_vector_type(2)));
__device__ __forceinline__ float wave_sum(float v) {
#pragma unroll
    for (int o = 1; o < 64; o <<= 1) v += __shfl_xor(v, o);
    return v;
}
__device__ __forceinline__ float sigm(float z) { return __builtin_amdgcn_rcpf(1.0f + __builtin_amdgcn_exp2f(z * -1.44269504089f)); }
__device__ __forceinline__ float gelu_t(float x) { const float z = x * (1.5957691216f + 0.0713548163f * x * x); return x * sigm(z); }
__device__ __forceinline__ float bflo(unsigned w) { return __builtin_bit_cast(float, w << 16); }
__device__ __forceinline__ float bfhi(unsigned w) { return __builtin_bit_cast(float, w & 0xffff0000u); }

__device__ __forceinline__ void p0_mod_gemv(const float* c, const float* w_ada, const float* b_ada, float* MOD, LAS unsigned char* lds, int vcu, int G, int tid, int lane, int wave) {
    constexpr int NCG = NMOD / 256, NKR = DM / 128;
    LAS float* red = (LAS float*)lds;
    for (int it = vcu; it < NCG * NKR; it += G) {
        const int cg = it % NCG, kr = it / NCG, k0 = kr * 128 + wave * 16, col = cg * 256 + lane * 4;
        float cv = c[k0 + (lane & 15)]; cv = cv * sigm(cv);
        f32x4 a = (f32x4){0.f, 0.f, 0.f, 0.f};
#pragma unroll
        for (int kk = 0; kk < 16; ++kk) { const float s = __shfl(cv, kk); const f32x4 w = __builtin_nontemporal_load((const f32x4*)(w_ada + (size_t)(k0 + kk) * NMOD + col)); a += w * s; }
        *(LAS f32x4*)(red + wave * 256 + lane * 4) = a;
        __syncthreads();
        if (tid < 256) { float s = 0.f;
#pragma unroll
            for (int w = 0; w < 8; ++w) s += red[w * 256 + tid];
            if (kr == 0) s += b_ada[cg * 256 + tid];
            atomicAdd(MOD + cg * 256 + tid, s); }
        __syncthreads();
    }
}
struct TrDesc { const float* W; bf16* WT; int N, dpitch, koff, item; };
__device__ __forceinline__ void tr_load(const TrDesc& d, int lane, float (&tmp)[32]) {
    const int nblk = d.N / 32, kb = d.item / nblk, nb = d.item % nblk, k0 = 64 * kb, n0 = 32 * nb;
    const float* src = d.W + (size_t)(k0 + (lane >> 5)) * d.N + n0 + (lane & 31);
#pragma unroll
    for (int i = 0; i < 32; ++i) tmp[i] = __builtin_nontemporal_load(src + (size_t)(2 * i) * d.N);
}
__device__ __forceinline__ void tr_store(const TrDesc& d, const float (&tmp)[32], LAS float* scr, int lane) {
    const int nblk = d.N / 32, kb = d.item / nblk, nb = d.item % nblk, k0 = 64 * kb, n0 = 32 * nb;
#pragma unroll
    for (int i = 0; i < 32; ++i) scr[(2 * i + (lane >> 5)) * 33 + (lane & 31)] = tmp[i];
    LDS_WAIT(); asm volatile("" ::: "memory");
    const int c = lane & 7;
#pragma unroll
    for (int j = 0; j < 4; ++j) { const int n = (lane >> 3) + 8 * j; const LAS float* s = scr + (8 * c) * 33 + n;
        v4u o; o.x = pg8::cvt_pk_bf16(s[0 * 33], s[1 * 33]); o.y = pg8::cvt_pk_bf16(s[2 * 33], s[3 * 33]); o.z = pg8::cvt_pk_bf16(s[4 * 33], s[5 * 33]); o.w = pg8::cvt_pk_bf16(s[6 * 33], s[7 * 33]);
        *(v4u*)(d.WT + (size_t)(n0 + n) * d.dpitch + d.koff + k0 + 8 * c) = o; }
    LDS_WAIT(); asm volatile("" ::: "memory");
}
template <class L> __device__ __forceinline__ void convert_list(const L& list, int n, int start, int stride, LAS float* scr, int lane) {
    float ta[32], tb[32]; TrDesc da, db; int it = start;
    if (it < n) { da = list.get(it); tr_load(da, lane, ta); }
    while (it < n) {
        int it2 = it + stride; if (it2 < n) { db = list.get(it2); tr_load(db, lane, tb); }
        tr_store(da, ta, scr, lane);
        it = it2; if (it >= n) break;
        it2 = it + stride; if (it2 < n) { da = list.get(it2); tr_load(da, lane, ta); }
        tr_store(db, tb, scr, lane);
        it = it2;
    }
}
struct ListOne { const float* W; bf16* WT; int N, dpitch, koff, first; __device__ __forceinline__ TrDesc get(int r) const { return TrDesc{W, WT, N, dpitch, koff, first + r}; } };
struct ListP0 {
    const float *win, *wpool; bf16 *Win_t, *WpT;
    static constexpr int I_IN = (DM / 64) * (INC / 32), I_P = (256 / 64) * (256 / 32), NITEMS = I_IN + 4 * I_P;
    __device__ __forceinline__ TrDesc get(int r) const {
        if (r < I_IN) return TrDesc{win, Win_t, INC, DM, 0, r}; r -= I_IN;
        const int gi = r / I_P; return TrDesc{wpool + (size_t)gi * 65536, WpT + (size_t)gi * 65536, 256, 256, 0, r % I_P};
    }
};
struct ListP2 {
    const float *wa, *wb, *wout, *wup; bf16 *Wab_t, *Wout_t, *Wup_t;
    static constexpr int I_A = (AW / 64) * (DM / 32), I_B = (BW / 64) * (DM / 32), I_O = (DM / 64) * (DM / 32), I_U = (DM / 64) * (FF2 / 32), NITEMS = I_A + I_B + I_O + I_U;
    __device__ __forceinline__ TrDesc get(int r) const {
        if (r < I_A) return TrDesc{wa, Wab_t, DM, KAB, 0, r}; r -= I_A;
        if (r < I_B) return TrDesc{wb, Wab_t, DM, KAB, AW, r}; r -= I_B;
        if (r < I_O) return TrDesc{wout, Wout_t, DM, DM, 0, r}; r -= I_O;
        return TrDesc{wup, Wup_t, FF2, DM, 0, r};
    }
};

typedef short v4s __attribute__((ext_vector_type(4)));
__device__ __forceinline__ void p3_spatial(LAS unsigned char* lds, int n, int h, const bf16* V, const bf16* U, const float* stats, const float* ln_g, const float* ln_b,
                                           const bf16* Wsp, const float* b_sp, bf16* SGPB, int tid, int lane, int wave) {
    LAS float* MR = (LAS float*)lds;
    LAS bf16* IM = (LAS bf16*)(lds + 2048);
    const int t0 = n * 128, d0 = h * 256;
    const int fr = lane & 15, fq = lane >> 4;
    float st_s = 0.f, st_q = 0.f;
    if (tid < 128) { st_s = stats[2 * (t0 + tid)]; st_q = stats[2 * (t0 + tid) + 1]; }
    const int c8 = (tid & 31) * 8, j0 = tid >> 5;
    v4u rawv[8];
#pragma unroll
    for (int it = 0; it < 8; ++it) rawv[it] = __builtin_nontemporal_load((const v4u*)(V + (size_t)(t0 + j0 + 16 * it) * AW + d0 + c8));
    const f32x4 g0 = *(const f32x4*)(ln_g + d0 + c8), g1 = *(const f32x4*)(ln_g + d0 + c8 + 4), b0 = *(const f32x4*)(ln_b + d0 + c8), b1 = *(const f32x4*)(ln_b + d0 + c8 + 4);
    const bf16* wbase = Wsp + (size_t)h * 16384;
    bf16x8 wf[4][8];
#pragma unroll
    for (int ks = 0; ks < 4; ++ks)
#pragma unroll
        for (int ib = 0; ib < 8; ++ib) if (32 * ks <= 16 * ib + 15) wf[ks][ib] = *(const bf16x8*)(wbase + (16 * ib + fr) * 128 + 32 * ks + 8 * fq);
    asm volatile("" ::: "memory");
    if (tid < 128) { const float mu = st_s * (1.0f / AW), var = fmaxf(st_q * (1.0f / AW) - mu * mu, 0.f), rstd = 1.0f / sqrtf(var + EPS);
        MR[2 * tid] = rstd; MR[2 * tid + 1] = -mu * rstd; }
    __syncthreads();
#pragma unroll
    for (int it = 0; it < 8; ++it) { const int j = j0 + 16 * it; const float rs = MR[2 * j], cc = MR[2 * j + 1]; const v4u raw = rawv[it];
        const f32x4 va = (f32x4){bflo(raw.x), bfhi(raw.x), bflo(raw.y), bfhi(raw.y)}, vb = (f32x4){bflo(raw.z), bfhi(raw.z), bflo(raw.w), bfhi(raw.w)};
        const f32x4 oa = (va * rs + cc) * g0 + b0, ob = (vb * rs + cc) * g1 + b1;
        v4u pk; pk.x = pg8::cvt_pk_bf16(oa[0], oa[1]); pk.y = pg8::cvt_pk_bf16(oa[2], oa[3]); pk.z = pg8::cvt_pk_bf16(ob[0], ob[1]); pk.w = pg8::cvt_pk_bf16(ob[2], ob[3]);
        *(LAS v4u*)(IM + j * 264 + c8) = pk; }
    __syncthreads();
    f32x4 acc[2][8];
#pragma unroll
    for (int a = 0; a < 2; ++a)
#pragma unroll
        for (int b = 0; b < 8; ++b) acc[a][b] = (f32x4){0.f, 0.f, 0.f, 0.f};
    const LAS bf16* trb = IM + (8 * fq + (fr >> 2)) * 264 + 32 * wave + 4 * (fr & 3);
#pragma unroll
    for (int ks = 0; ks < 4; ++ks) {
        bf16x8 a[2];
#pragma unroll
        for (int dbi = 0; dbi < 2; ++dbi) {
            const v4s lo = __builtin_amdgcn_ds_read_tr16_b64_v4i16((LAS v4s*)(trb + (32 * ks) * 264 + 16 * dbi));
            const v4s hi = __builtin_amdgcn_ds_read_tr16_b64_v4i16((LAS v4s*)(trb + (32 * ks + 4) * 264 + 16 * dbi));
            a[dbi] = (bf16x8){lo[0], lo[1], lo[2], lo[3], hi[0], hi[1], hi[2], hi[3]}; }
#pragma unroll
        for (int ib = 0; ib < 8; ++ib) {
            if (32 * ks <= 16 * ib + 15) {
                const bf16x8 b = wf[ks][ib];
#pragma unroll
                for (int dbi = 0; dbi < 2; ++dbi) acc[dbi][ib] = __builtin_amdgcn_mfma_f32_16x16x32_bf16(a[dbi], b, acc[dbi][ib], 0, 0, 0);
            }
        }
    }
    v4u uu[8];
#pragma unroll
    for (int it = 0; it < 8; ++it) { const int idx = tid + 512 * it; uu[it] = __builtin_nontemporal_load((const v4u*)(U + (size_t)(t0 + (idx >> 5)) * AW + d0 + (idx & 31) * 8)); }
    __syncthreads();
    LAS bf16* OUT = IM;
#pragma unroll
    for (int ib = 0; ib < 8; ++ib) { const int i = 16 * ib + fr; const float bs = b_sp[h * 128 + i];
#pragma unroll
        for (int dbi = 0; dbi < 2; ++dbi) { const f32x4 m = acc[dbi][ib] + bs;
            v2u o; o.x = pg8::cvt_pk_bf16(m[0], m[1]); o.y = pg8::cvt_pk_bf16(m[2], m[3]);
            *(LAS v2u*)(OUT + i * 264 + 16 * (2 * wave + dbi) + 4 * fq) = o; } }
    __syncthreads();
#pragma unroll
    for (int it = 0; it < 8; ++it) { const int idx = tid + 512 * it, i = idx >> 5, cc8 = (idx & 31) * 8;
        const v4u mx = *(const LAS v4u*)(OUT + i * 264 + cc8); const v4u ux = uu[it];
        v4u o; o.x = pg8::cvt_pk_bf16(bflo(ux.x) * bflo(mx.x), bfhi(ux.x) * bfhi(mx.x)); o.y = pg8::cvt_pk_bf16(bflo(ux.y) * bflo(mx.y), bfhi(ux.y) * bfhi(mx.y));
        o.z = pg8::cvt_pk_bf16(bflo(ux.z) * bflo(mx.z), bfhi(ux.z) * bfhi(mx.z)); o.w = pg8::cvt_pk_bf16(bflo(ux.w) * bflo(mx.w), bfhi(ux.w) * bfhi(mx.w));
        *(v4u*)(SGPB + (size_t)(t0 + i) * KAB + d0 + cc8) = o; }
}
__device__ __forceinline__ void p3_pool(LAS unsigned char* lds, int r, int gi, const bf16* P, const bf16* WpT, const float* pscale, bf16* SGPB, int tid, int lane, int wave) {
    LAS bf16* Ap = (LAS bf16*)lds;
    const int t0 = r * 128, win = 2 << gi;
    const int fr = lane & 15, fq = lane >> 4;
    const bf16* wbase = WpT + (size_t)gi * 65536;
    bf16x8 af[8][2];
#pragma unroll
    for (int ks = 0; ks < 8; ++ks)
#pragma unroll
        for (int ebi = 0; ebi < 2; ++ebi) af[ks][ebi] = *(const bf16x8*)(wbase + (16 * (2 * wave + ebi) + fr) * 256 + 32 * ks + 8 * fq);
    {
        const int q8 = (tid & 31) * 8, tl0 = (tid >> 5) * 8; const bf16* pc = P + gi * 256 + q8;
        float sum[8] = {0.f, 0.f, 0.f, 0.f, 0.f, 0.f, 0.f, 0.f};
#pragma unroll
        for (int sI = 1; sI < 16; ++sI) { const int ts = t0 + tl0 - sI; const float fct = (sI < win && ts >= 0) ? 1.f : 0.f;
            const v4u raw = *(const v4u*)(pc + (size_t)(ts >= 0 ? ts : 0) * BW);
            sum[0] += fct * bflo(raw.x); sum[1] += fct * bfhi(raw.x); sum[2] += fct * bflo(raw.y); sum[3] += fct * bfhi(raw.y); sum[4] += fct * bflo(raw.z); sum[5] += fct * bfhi(raw.z); sum[6] += fct * bflo(raw.w); sum[7] += fct * bfhi(raw.w); }
#pragma unroll
        for (int k = 0; k < 8; ++k) { const int t = t0 + tl0 + k; const v4u raw = *(const v4u*)(pc + (size_t)t * BW);
            const float self[8] = {bflo(raw.x), bfhi(raw.x), bflo(raw.y), bfhi(raw.y), bflo(raw.z), bfhi(raw.z), bflo(raw.w), bfhi(raw.w)};
#pragma unroll
            for (int e = 0; e < 8; ++e) sum[e] += self[e];
            const int cnt = (t + 1 < win) ? (t + 1) : win; const float inv = 1.0f / (float)cnt;
            v4u o; o.x = pg8::cvt_pk_bf16(sum[0] * inv - self[0], sum[1] * inv - self[1]); o.y = pg8::cvt_pk_bf16(sum[2] * inv - self[2], sum[3] * inv - self[3]);
            o.z = pg8::cvt_pk_bf16(sum[4] * inv - self[4], sum[5] * inv - self[5]); o.w = pg8::cvt_pk_bf16(sum[6] * inv - self[6], sum[7] * inv - self[7]);
            *(LAS v4u*)(Ap + (tl0 + k) * 264 + q8) = o;
            const int td = t - win + 1;
            { const float fct = (td >= 0) ? 1.f : 0.f; const v4u rd = *(const v4u*)(pc + (size_t)(td >= 0 ? td : 0) * BW);
                sum[0] -= fct * bflo(rd.x); sum[1] -= fct * bfhi(rd.x); sum[2] -= fct * bflo(rd.y); sum[3] -= fct * bfhi(rd.y); sum[4] -= fct * bflo(rd.z); sum[5] -= fct * bfhi(rd.z); sum[6] -= fct * bflo(rd.w); sum[7] -= fct * bfhi(rd.w); } }
    }
    __syncthreads();
    f32x4 acc[2][8];
#pragma unroll
    for (int a = 0; a < 2; ++a)
#pragma unroll
        for (int b = 0; b < 8; ++b) acc[a][b] = (f32x4){0.f, 0.f, 0.f, 0.f};
#pragma unroll
    for (int ks = 0; ks < 8; ++ks) {
        bf16x8 a[2];
#pragma unroll
        for (int ebi = 0; ebi < 2; ++ebi) a[ebi] = af[ks][ebi];
#pragma unroll
        for (int tb = 0; tb < 8; ++tb) { const bf16x8 b = *(const LAS bf16x8*)(Ap + (16 * tb + fr) * 264 + 32 * ks + 8 * fq);
#pragma unroll
            for (int ebi = 0; ebi < 2; ++ebi) acc[ebi][tb] = __builtin_amdgcn_mfma_f32_16x16x32_bf16(a[ebi], b, acc[ebi][tb], 0, 0, 0); }
    }
    __syncthreads();
#pragma unroll
    for (int ebi = 0; ebi < 2; ++ebi) { const int e = 16 * (2 * wave + ebi) + 4 * fq; const f32x4 sc = *(const f32x4*)(pscale + gi * 256 + e);
#pragma unroll
        for (int tb = 0; tb < 8; ++tb) { const f32x4 m = acc[ebi][tb] * sc;
            v2u o; o.x = pg8::cvt_pk_bf16(m[0], m[1]); o.y = pg8::cvt_pk_bf16(m[2], m[3]);
            *(LAS v2u*)(Ap + (16 * tb + fr) * 264 + e) = o; } }
    __syncthreads();
#pragma unroll
    for (int it = 0; it < 8; ++it) { const int idx = tid + 512 * it, t = idx >> 5, c8 = (idx & 31) * 8;
        *(v4u*)(SGPB + (size_t)(t0 + t) * KAB + AW + gi * 256 + c8) = *(const LAS v4u*)(Ap + t * 264 + c8); }
}

struct Params { const float* in[22]; float* out; unsigned char* ws; int ph_lo, ph_hi; };
enum { I_X = 0, I_C, I_WADA, I_BADA, I_GPREMIX, I_GPOSTMIX, I_WIN, I_LNG, I_LNB, I_WSP, I_BSP, I_WPOOL, I_PSCALE, I_WA, I_WB, I_WOUT, I_GPREFFN, I_GPOSTFFN, I_WUP, I_CONVW, I_CONVB, I_WDN };

__global__ void __launch_bounds__(NWAVES * 64, 2) fwd_megakernel(Params p) {
    extern __shared__ __attribute__((aligned(16))) unsigned char lds_raw[];
    LAS unsigned char* lds = (LAS unsigned char*)lds_raw;
    volatile LAS unsigned* MISC = (volatile LAS unsigned*)(lds + MISC_OFF);
    const int tid = threadIdx.x, lane = tid & 63, wave = __builtin_amdgcn_readfirstlane(tid >> 6);
    const int G = gridDim.x, bx = blockIdx.x, vcu = (G % 8 == 0) ? (bx % 8) * (G / 8) + bx / 8 : bx;
    const int gw = vcu * NWAVES + wave, NGW = G * NWAVES;
    unsigned char* ws = p.ws;
    for (int u = tid; u < (LDS_BYTES - LDSCTL_OFF) / 4; u += NWAVES * 64) ((LAS unsigned*)(lds + LDSCTL_OFF))[u] = 0u;
    __syncthreads();
    const int lo = p.ph_lo, hi = p.ph_hi;
    XcdBarrier bar; bar.bar = (unsigned*)(ws + WS_CTL) + CW_BAR; bar.x = 0; bar.st = nullptr;
    if (hi - lo > 1) bar = xcd_barrier_post((unsigned*)(ws + WS_CTL) + CW_BAR, MISC + 8);
#define IN(k) (lo <= (k) && (k) < hi)
#define SEAM(k) do { if (IN(k) && IN((k) + 1)) xcd_barrier(bar); } while (0)

    float* MOD = (float*)(ws + WS_MOD); float* STATS = (float*)(ws + WS_STATS); float* VEC = (float*)(ws + WS_VEC);
    bf16 *Win_t = (bf16*)(ws + WS_WIN), *Wab_t = (bf16*)(ws + WS_WAB), *Wout_t = (bf16*)(ws + WS_WOUT), *Wup_t = (bf16*)(ws + WS_WUP), *Wdn_t = (bf16*)(ws + WS_WDN), *WpT = (bf16*)(ws + WS_WPOOL), *Wsp = (bf16*)(ws + WS_WSP);
    bf16 *H1 = (bf16*)(ws + WS_H1), *Ub = (bf16*)(ws + WS_U), *Vb = (bf16*)(ws + WS_V), *Pb = (bf16*)(ws + WS_P), *GA = (bf16*)(ws + WS_GA), *GB = (bf16*)(ws + WS_GB);
    bf16 *SGPB = (bf16*)(ws + WS_SGPB), *MERGED = (bf16*)(ws + WS_MERGED), *ACT = (bf16*)(ws + WS_ACT), *H2 = (bf16*)(ws + WS_H2);
    float *MIX = (float*)(ws + WS_MIX), *Y = (float*)(ws + WS_Y), *RAWB = (float*)(ws + WS_RAWB);
    const float* x = p.in[I_X]; float* out = p.out;

    unsigned* const gcnt = (unsigned*)(ws + WS_CTL) + 16;
    const bool split = false;
    const bool gemv_role = !split || (((bx >> 3) & 1) == 0);
    const int n_gemv = split ? G / 2 : G, i_gemv = split ? (bx >> 4) * 8 + (bx & 7) : vcu, n_conv = split ? G / 2 : G, i_conv = split ? (bx >> 4) * 8 + (bx & 7) : vcu;
    if (IN(0)) {
        if (gemv_role) {
            p0_mod_gemv(p.in[I_C], p.in[I_WADA], p.in[I_BADA], MOD, lds + RING_OFF, i_gemv, n_gemv, tid, lane, wave);
            VM_WAIT(); __syncthreads();
            if (tid == 0) __hip_atomic_fetch_add(gcnt, 1u, RLX_AGENT);
        }
        if (!split || !gemv_role) { LAS float* scr = (LAS float*)(lds + RING_OFF + wave * 16384);
            const ListP0 L{p.in[I_WIN], p.in[I_WPOOL], Win_t, WpT}; convert_list(L, ListP0::NITEMS, i_conv * NWAVES + wave, n_conv * NWAVES, scr, lane); }
        for (int idx = gw * 64 + lane; idx < 8 * 128 * 128; idx += NGW * 64) { const int i = (idx >> 7) & 127, j = idx & 127; Wsp[idx] = (bf16)((j <= i) ? f2bf(p.in[I_WSP][idx]) : 0u); }
    }
    if (IN(0) && IN(1)) {
        if (wave == 0) { unsigned sp = 0;
            while ((unsigned)__builtin_amdgcn_readfirstlane(__hip_atomic_load(gcnt, RLX_AGENT)) < (unsigned)n_gemv) { __builtin_amdgcn_s_sleep(2); if (++sp > (1u << 20)) break; }
            __builtin_amdgcn_fence(__ATOMIC_ACQUIRE, "agent"); VM_WAIT(); }
        __syncthreads();
    }
    if (IN(1)) {
        if (bx == 0) for (int cc = tid; cc < DM; cc += NWAVES * 64) {
            VEC[cc] = MOD[2 * DM + cc] * p.in[I_GPOSTMIX][cc];
            VEC[DM + cc] = p.in[I_GPREFFN][cc] * (1.0f + MOD[4 * DM + cc]);
            VEC[2 * DM + cc] = MOD[3 * DM + cc];
            VEC[3 * DM + cc] = MOD[5 * DM + cc] * p.in[I_GPOSTFFN][cc]; }
        f32x4 ca[8], cb[8];
#pragma unroll
        for (int j = 0; j < 8; ++j) { const int cc = 8 * lane + 512 * (j >> 1) + 4 * (j & 1); const f32x4 g = *(const f32x4*)(p.in[I_GPREMIX] + cc), sc = *(const f32x4*)(MOD + DM + cc); ca[j] = g * (sc + 1.0f); cb[j] = *(const f32x4*)(MOD + cc); }
        {   int m = gw; f32x4 v[8], nx[8];
            if (m < SEQ) { const f32x4* xr = (const f32x4*)(x + (size_t)m * DM) + 2 * lane;
#pragma unroll
                for (int j = 0; j < 8; ++j) v[j] = __builtin_nontemporal_load(xr + 128 * (j >> 1) + (j & 1)); }
            for (; m < SEQ; m += NGW) {
                const int mn = (m + NGW < SEQ) ? m + NGW : m;
                { const f32x4* xr = (const f32x4*)(x + (size_t)mn * DM) + 2 * lane;
#pragma unroll
                  for (int j = 0; j < 8; ++j) nx[j] = __builtin_nontemporal_load(xr + 128 * (j >> 1) + (j & 1)); }
                asm volatile("" ::: "memory");
                float ss = 0.f;
#pragma unroll
                for (int j = 0; j < 8; ++j) ss += (v[j][0] * v[j][0] + v[j][1] * v[j][1]) + (v[j][2] * v[j][2] + v[j][3] * v[j][3]);
                const float rstd = 1.0f / sqrtf(wave_sum(ss) * (1.0f / DM) + EPS);
                v4u* o16 = (v4u*)(H1 + (size_t)m * DM) + lane;
#pragma unroll
                for (int jq = 0; jq < 4; ++jq) { const f32x4 ha = v[2 * jq] * rstd * ca[2 * jq] + cb[2 * jq], hb = v[2 * jq + 1] * rstd * ca[2 * jq + 1] + cb[2 * jq + 1];
                    v4u o; o.x = pg8::cvt_pk_bf16(ha[0], ha[1]); o.y = pg8::cvt_pk_bf16(ha[2], ha[3]); o.z = pg8::cvt_pk_bf16(hb[0], hb[1]); o.w = pg8::cvt_pk_bf16(hb[2], hb[3]); o16[64 * jq] = o; }
#pragma unroll
                for (int j = 0; j < 8; ++j) v[j] = nx[j];
            }
        }
    }
    SEAM(1);
    if (IN(2)) {
        pg8::Gemm g{H1, Win_t, SEQ, INC, DM}; pg8::StaticOrder S; S.init(SEQ, INC, G, bx);
        pg8::EpiIn E{Ub, Vb, Pb, GA, GB, STATS};
        pg8::gemm_phase<pg8::EpiIn, pg8::StaticOrder, true, true, 16>(lds + RING_OFF, g, S, E);
        {
            const int rem = (32 * 36) % G, nidle = rem ? G - rem : G, idle = rem ? bx - rem : bx;
            if (idle >= 0) { LAS float* scr = (LAS float*)(lds + RING_OFF + wave * 16384);
                const ListP2 L{p.in[I_WA], p.in[I_WB], p.in[I_WOUT], p.in[I_WUP], Wab_t, Wout_t, Wup_t}; convert_list(L, ListP2::NITEMS, idle * NWAVES + wave, nidle * NWAVES, scr, lane); }
        }
    }
    SEAM(2);
    if (IN(3)) {
        for (int u = vcu; u < 768; u += G) {
            __syncthreads();
            if (u < 512) p3_spatial(lds + RING_OFF, u >> 3, u & 7, Vb, Ub, STATS, p.in[I_LNG], p.in[I_LNB], Wsp, p.in[I_BSP], SGPB, tid, lane, wave);
            else p3_pool(lds + RING_OFF, (u - 512) >> 2, (u - 512) & 3, Pb, WpT, p.in[I_PSCALE], SGPB, tid, lane, wave);
        }
        __syncthreads();
    }
    SEAM(3);
    if (IN(4)) {
        pg8::Gemm g{SGPB, Wab_t, SEQ, DM, KAB}; pg8::StaticOrder S; S.init(SEQ, DM, G, bx);
        pg8::EpiMerge E{GA, GB, MERGED};
        pg8::gemm_phase<pg8::EpiMerge, pg8::StaticOrder, true, true>(lds + RING_OFF, g, S, E);
    }
    SEAM(4);
    const bool fuse = (G == 256);
    unsigned* const xb = (unsigned*)(ws + WS_XBUF); unsigned* const pc = (unsigned*)(ws + WS_CNT); unsigned* const tmo = (unsigned*)(ws + WS_CTL) + 2;
    if (IN(5)) {
        pg8::Gemm g{MERGED, Wout_t, SEQ, DM, DM}; pg8::StaticOrder S; S.init(SEQ, DM, G, bx);
        if (fuse) {
            pg8::EpiMixFused E{x, (bf16*)(ws + WS_Y), H2, VEC, pg8::PanelSS{xb, pc, tmo, EPS}, pg8::PanelSS{xb + 65536, pc + 2048, tmo, EPS}};
            pg8::gemm_phase<pg8::EpiMixFused, pg8::StaticOrder, false, true>(lds + RING_OFF, g, S, E);
        } else {
            pg8::EpiF32 E{MIX, DM};
            pg8::gemm_phase<pg8::EpiF32, pg8::StaticOrder, true, true>(lds + RING_OFF, g, S, E);
        }
    }
    if (!fuse) SEAM(5);
    if (IN(6) && !fuse) {
        {   int m = gw; f32x4 v[8], w[8], nv[8], nw[8];
            if (m < SEQ) { const f32x4* xr = (const f32x4*)(x + (size_t)m * DM) + lane; const f32x4* mr = (const f32x4*)(MIX + (size_t)m * DM) + lane;
#pragma unroll
                for (int j = 0; j < 8; ++j) { v[j] = xr[64 * j]; w[j] = mr[64 * j]; } }
            for (; m < SEQ; m += NGW) {
                const int mn = (m + NGW < SEQ) ? m + NGW : m;
                { const f32x4* xr = (const f32x4*)(x + (size_t)mn * DM) + lane; const f32x4* mr = (const f32x4*)(MIX + (size_t)mn * DM) + lane;
#pragma unroll
                  for (int j = 0; j < 8; ++j) { nv[j] = xr[64 * j]; nw[j] = mr[64 * j]; } }
                asm volatile("" ::: "memory");
                float ss = 0.f;
#pragma unroll
                for (int j = 0; j < 8; ++j) ss += (w[j][0] * w[j][0] + w[j][1] * w[j][1]) + (w[j][2] * w[j][2] + w[j][3] * w[j][3]);
                const float rstd = 1.0f / sqrtf(wave_sum(ss) * (1.0f / DM) + EPS); float s1 = 0.f;
                f32x4* o4 = (f32x4*)(out + (size_t)m * DM) + lane;
#pragma unroll
                for (int j = 0; j < 8; ++j) { const f32x4 g1 = *((const f32x4*)VEC + lane + 64 * j); v[j] = v[j] + g1 * (w[j] * rstd); o4[64 * j] = v[j];
                    s1 += (v[j][0] * v[j][0] + v[j][1] * v[j][1]) + (v[j][2] * v[j][2] + v[j][3] * v[j][3]); }
                const float rstd1 = 1.0f / sqrtf(wave_sum(s1) * (1.0f / DM) + EPS);
                uint2* o8 = (uint2*)(H2 + (size_t)m * DM) + lane;
#pragma unroll
                for (int j = 0; j < 8; ++j) { const f32x4 a2 = *((const f32x4*)(VEC + DM) + lane + 64 * j), b2 = *((const f32x4*)(VEC + 2 * DM) + lane + 64 * j);
                    const f32x4 h = v[j] * rstd1 * a2 + b2; uint2 o; o.x = pk2(h[0], h[1]); o.y = pk2(h[2], h[3]); o8[64 * j] = o; }
#pragma unroll
                for (int j = 0; j < 8; ++j) { v[j] = nv[j]; w[j] = nw[j]; }
            }
        }
    }
    SEAM(6);
    if (IN(7)) {
        pg8::Gemm g{H2, Wup_t, SEQ, FF2, DM, (size_t)FF * DM * 2, (size_t)128 * DM * 2}; pg8::StaticOrder S; S.init(SEQ, FF2, G, bx);
        pg8::EpiUpConv E{ACT, RAWB, p.in[I_CONVW], p.in[I_CONVB], lds + XCH_OFF};
        pg8::gemm_phase<pg8::EpiUpConv, pg8::StaticOrder, true, true, 0>(lds + RING_OFF, g, S, E);
        {
            const int rem = (32 * 44) % G, nidle = rem ? G - rem : G, idle = rem ? bx - rem : bx;
            if (idle >= 0) { LAS float* scr = (LAS float*)(lds + RING_OFF + wave * 16384);
                const ListOne L{p.in[I_WDN], Wdn_t, DM, FF, 0, 0}; convert_list(L, (FF / 64) * (DM / 32), idle * NWAVES + wave, nidle * NWAVES, scr, lane); }
        }
    }
    SEAM(7);
    if (IN(8)) {
        pg8::Gemm g{ACT, Wdn_t, SEQ, DM, FF}; pg8::FixOrder S; S.init(SEQ, DM, G, bx); S.ACT = ACT; S.RAWB = RAWB; S.cw = p.in[I_CONVW]; S.cb = p.in[I_CONVB];
        if (fuse) {
            pg8::EpiOutFused E{(const bf16*)(ws + WS_Y), out, VEC, pg8::PanelSS{xb + 2 * 65536, pc + 2 * 2048, tmo, EPS}};
            pg8::gemm_phase<pg8::EpiOutFused, pg8::FixOrder, false, true>(lds + RING_OFF, g, S, E);
        } else {
            pg8::EpiF32 E{Y, DM};
            pg8::gemm_phase<pg8::EpiF32, pg8::FixOrder, true, true>(lds + RING_OFF, g, S, E);
        }
    }
    if (!fuse) SEAM(8);
    if (IN(9) && !fuse) {
        {   int m = gw; f32x4 v[8], w[8], nv[8], nw[8];
            if (m < SEQ) { const f32x4* xr = (const f32x4*)(out + (size_t)m * DM) + lane; const f32x4* yr = (const f32x4*)(Y + (size_t)m * DM) + lane;
#pragma unroll
                for (int j = 0; j < 8; ++j) { v[j] = xr[64 * j]; w[j] = yr[64 * j]; } }
            for (; m < SEQ; m += NGW) {
                const bool has = (m + NGW < SEQ); const int mn = has ? m + NGW : m;
                if (has) { const f32x4* xr = (const f32x4*)(out + (size_t)mn * DM) + lane; const f32x4* yr = (const f32x4*)(Y + (size_t)mn * DM) + lane;
#pragma unroll
                  for (int j = 0; j < 8; ++j) { nv[j] = xr[64 * j]; nw[j] = yr[64 * j]; } }
                asm volatile("" ::: "memory");
                float ss = 0.f;
#pragma unroll
                for (int j = 0; j < 8; ++j) ss += (w[j][0] * w[j][0] + w[j][1] * w[j][1]) + (w[j][2] * w[j][2] + w[j][3] * w[j][3]);
                const float rstd = 1.0f / sqrtf(wave_sum(ss) * (1.0f / DM) + EPS);
                f32x4* o4 = (f32x4*)(out + (size_t)m * DM) + lane;
#pragma unroll
                for (int j = 0; j < 8; ++j) { const f32x4 g2 = *((const f32x4*)(VEC + 3 * DM) + lane + 64 * j); o4[64 * j] = v[j] + g2 * (w[j] * rstd); }
                if (has) {
#pragma unroll
                    for (int j = 0; j < 8; ++j) { v[j] = nv[j]; w[j] = nw[j]; } }
            }
        }
    }
#undef IN
#undef SEAM
}

extern "C" void kernel_launch(void* const* d_in, const int* in_sizes, int n_in, void* d_out, int out_size, void* d_ws, size_t ws_size, hipStream_t stream) {
    static int grid = 0;
    if (grid == 0) {
        if (n_in != 22 || in_sizes[0] != SEQ * DM || out_size != SEQ * DM || ws_size < WS_END) { fprintf(stderr, "kernel_launch: unexpected shapes (n_in %d, in0 %d, out %d, ws %zu < %zu)\n", n_in, n_in > 0 ? in_sizes[0] : -1, out_size, ws_size, (size_t)WS_END); grid = -1; return; }
        int dev = 0, cus = 0, per_cu = 0;
        if (hipGetDevice(&dev) != hipSuccess || hipDeviceGetAttribute(&cus, hipDeviceAttributeMultiprocessorCount, dev) != hipSuccess) { grid = -1; return; }
        if (hipFuncSetAttribute((const void*)fwd_megakernel, hipFuncAttributeMaxDynamicSharedMemorySize, LDS_BYTES) != hipSuccess) { fprintf(stderr, "kernel_launch: hipFuncSetAttribute failed\n"); grid = -1; return; }
        if (hipOccupancyMaxActiveBlocksPerMultiprocessor(&per_cu, (const void*)fwd_megakernel, NWAVES * 64, LDS_BYTES) != hipSuccess || per_cu < 1) { fprintf(stderr, "kernel_launch: occupancy query says %d blocks per CU\n", per_cu); grid = -1; (void)hipGetLastError(); return; }
        grid = cus;
    }
    if (grid < 0) return;
    (void)hipMemsetAsync((char*)d_ws + WS_CTL, 0, CTL_ZERO_BYTES, stream);
    Params a{};
    for (int i = 0; i < 22; ++i) a.in[i] = (const float*)d_in[i];
    a.out = (float*)d_out; a.ws = (unsigned char*)d_ws;
#if defined(PROBE_DUP)
    a.ph_lo = 0; a.ph_hi = PROBE_DUP + 1;
    hipLaunchKernelGGL(fwd_megakernel, dim3(grid), dim3(NWAVES * 64), LDS_BYTES, stream, a);
    (void)hipMemsetAsync((char*)d_ws + WS_CTL, 0, WS_MOD, stream);
    if (PROBE_DUP == 0) (void)hipMemsetAsync((char*)d_ws + WS_MOD, 0, NMOD * 4, stream);
    if (PROBE_DUP <= 2) (void)hipMemsetAsync((char*)d_ws + WS_STATS, 0, SEQ * 8, stream);
    a.ph_lo = PROBE_DUP; a.ph_hi = NPHASES;
    hipLaunchKernelGGL(fwd_megakernel, dim3(grid), dim3(NWAVES * 64), LDS_BYTES, stream, a);
#else
    for (int li = 0; li < N_LAUNCHES; ++li) {
        a.ph_lo = (N_LAUNCHES == 1) ? 0 : li; a.ph_hi = (N_LAUNCHES == 1) ? NPHASES : li + 1;
        hipLaunchKernelGGL(fwd_megakernel, dim3(grid), dim3(NWAVES * 64), LDS_BYTES, stream, a);
    }
#endif
}
```

```cpp
#include <hip/hip_runtime.h>
#include <cstdio>
#include <cstdint>
namespace pg8 {
#define PG8_LAS __attribute__((address_space(3)))
typedef unsigned short bf16_t;
typedef short bf16x8 __attribute__((ext_vector_type(8)));
typedef float f32x4 __attribute__((ext_vector_type(4)));
typedef unsigned u32x4 __attribute__((ext_vector_type(4)));
constexpr int BM = 256, BK = 64, HALF = 128, HTB = HALF * BK * 2  , STAGE_BYTES = 8 * HTB, NXCD = 8, WGM = 8;

__host__ __device__ __forceinline__ int lds_byte(int r, int c) { const int st = (r >> 4) * 2 + (c >> 5), rr = r & 15, cc = c & 31, ob = rr * 64 + cc * 2; return st * 1024 + (ob ^ (((ob >> 9) & 1) << 5)); }
__host__ __device__ __forceinline__ void stage_rc(int b, int& R, int& C) { const int st = b / 1024, sb = b % 1024, swz = sb ^ (((sb >> 9) & 1) << 5); R = (st >> 1) * 16 + swz / 64; C = (st & 1) * 32 + (swz % 64) / 2; }
__host__ __device__ __forceinline__ int perm32(int rho) { const int n = rho >> 4, i = rho & 15; return 8 * (i >> 2) + 4 * n + (i & 3); }

struct Unit { int pm, pn; };
struct Gemm { const bf16_t* A; const bf16_t* Bt; int M, N, K; size_t b_hstep, b_tstep; };

struct StaticOrder {
    int nM, nN, nwg, G, c;
    __host__ __device__ void init(int M, int N, int G_, int c_) { nM = M / BM; nN = N / BM; nwg = nM * nN; G = G_; c = c_; }
    __host__ __device__ bool next(int i, Unit& u) const {
        const long L = (long)i * G + c; if (L >= nwg) return false;
        int wgid = (int)L; { const int q = nwg / NXCD, r = nwg % NXCD, xcd = wgid % NXCD, off = wgid / NXCD; wgid = (xcd < r ? xcd * (q + 1) : r * (q + 1) + (xcd - r) * q) + off; }
        const int nig = WGM * nN, gid = wgid / nig, fm = gid * WGM, gsz = (nM - fm) < WGM ? (nM - fm) : WGM;
        u.pm = fm + ((wgid % nig) % gsz); u.pn = (wgid % nig) / gsz; return true;
    }
    __device__ __forceinline__ void a_ready(const Unit&) const {}
    __device__ __forceinline__ void done(const Unit&) const {}
};

__device__ __forceinline__ unsigned cvt_pk_bf16(float lo, float hi) { unsigned r; asm volatile("v_cvt_pk_bf16_f32 %0, %1, %2" : "=v"(r) : "v"(lo), "v"(hi)); return r; }
__device__ __forceinline__ float bf_lo(unsigned w) { return __builtin_bit_cast(float, w << 16); }
__device__ __forceinline__ float bf_hi(unsigned w) { return __builtin_bit_cast(float, w & 0xffff0000u); }
__device__ __forceinline__ float sigmoid_f(float z) { return __builtin_amdgcn_rcpf(1.0f + __builtin_amdgcn_exp2f(z * -1.44269504089f)); }
__device__ __forceinline__ float gelu_tanh_f(float x) { const float z = x * (1.5957691216f + 0.0713548163f * x * x); return x * sigmoid_f(z); }

typedef float f32x2 __attribute__((ext_vector_type(2)));
__device__ __forceinline__ f32x2 gelu_pk(f32x2 x) { const f32x2 t = (x * x) * (-0.102943264f) + (-2.302208198f); const f32x2 z = x * t;
    f32x2 e; e.x = __builtin_amdgcn_exp2f(z.x); e.y = __builtin_amdgcn_exp2f(z.y); e = e + 1.0f; f32x2 r; r.x = __builtin_amdgcn_rcpf(e.x); r.y = __builtin_amdgcn_rcpf(e.y); return x * r; }
__device__ __forceinline__ f32x2 sigmoid_pk(f32x2 x) { const f32x2 z = x * (-1.44269504089f);
    f32x2 e; e.x = __builtin_amdgcn_exp2f(z.x); e.y = __builtin_amdgcn_exp2f(z.y); e = e + 1.0f; f32x2 r; r.x = __builtin_amdgcn_rcpf(e.x); r.y = __builtin_amdgcn_rcpf(e.y); return r; }
__device__ __forceinline__ f32x4 gelu_v4(f32x4 v) { const f32x2 a = gelu_pk((f32x2){v[0], v[1]}), b = gelu_pk((f32x2){v[2], v[3]}); return (f32x4){a.x, a.y, b.x, b.y}; }
__device__ __forceinline__ f32x4 sigmoid_v4(f32x4 v) { const f32x2 a = sigmoid_pk((f32x2){v[0], v[1]}), b = sigmoid_pk((f32x2){v[2], v[3]}); return (f32x4){a.x, a.y, b.x, b.y}; }

struct EpiIn {
    static constexpr bool PERM = true, AFTER_DRAIN = false; static constexpr int MIDK = 0;
    bf16_t *U, *V, *P, *GA, *GB; float* stats;
    __device__ __forceinline__ void mid(f32x4 (&)[2][2][4][2], const Unit&, int, int, int, int) const {}
    __device__ __forceinline__ void operator()(const f32x4 (&acc)[2][2][4][2], const Unit& u, int wr, int wc, int fr, int fq) const {
        const int pn = u.pn; bf16_t* base; int ldc, colt, act;
        if (pn < 8) { base = U; ldc = 2048; colt = pn * BM; act = 1; }
        else if (pn < 16) { base = V; ldc = 2048; colt = (pn - 8) * BM; act = 3; }
        else if (pn < 20) { base = P; ldc = 1024; colt = (pn - 16) * BM; act = 0; }
        else if (pn < 28) { base = GA; ldc = 2048; colt = (pn - 20) * BM; act = 2; }
        else { base = GB; ldc = 2048; colt = (pn - 28) * BM; act = 2; }
        const int row0 = u.pm * BM + wr * 64 + fr, col0 = colt + wc * 32 + 8 * fq;
#pragma unroll
        for (int ai = 0; ai < 2; ++ai)
#pragma unroll
            for (int m = 0; m < 4; ++m) { const int row = row0 + ai * HALF + m * 16; bf16_t* rowp = base + (size_t)row * ldc + col0; float s = 0.f, q = 0.f;
#pragma unroll
                for (int bj = 0; bj < 2; ++bj) { f32x4 v0 = acc[ai][bj][m][0], v1 = acc[ai][bj][m][1];
                    if (act == 1 || act == 3) { v0 = gelu_v4(v0); v1 = gelu_v4(v1); }
                    else if (act == 2) { v0 = sigmoid_v4(v0); v1 = sigmoid_v4(v1); }
                    if (act == 3) {
#pragma unroll
                        for (int j = 0; j < 4; ++j) { s += v0[j] + v1[j]; q += v0[j] * v0[j] + v1[j] * v1[j]; } }
                    u32x4 w; w.x = cvt_pk_bf16(v0[0], v0[1]); w.y = cvt_pk_bf16(v0[2], v0[3]); w.z = cvt_pk_bf16(v1[0], v1[1]); w.w = cvt_pk_bf16(v1[2], v1[3]);
                    *(u32x4*)(rowp + bj * HALF) = w; }
                if (act == 3) { s += __shfl_xor(s, 16); s += __shfl_xor(s, 32); q += __shfl_xor(q, 16); q += __shfl_xor(q, 32);
                    if (fq == 0) { atomicAdd(stats + 2 * row, s); atomicAdd(stats + 2 * row + 1, q); } } }
    }
};
struct EpiBf16Plain {
    static constexpr bool PERM = true, AFTER_DRAIN = false; static constexpr int MIDK = 0;
    bf16_t* O; int ldc;
    __device__ __forceinline__ void mid(f32x4 (&)[2][2][4][2], const Unit&, int, int, int, int) const {}
    __device__ __forceinline__ void operator()(const f32x4 (&acc)[2][2][4][2], const Unit& u, int wr, int wc, int fr, int fq) const {
        const int row0 = u.pm * BM + wr * 64 + fr, col0 = u.pn * BM + wc * 32 + 8 * fq;
#pragma unroll
        for (int ai = 0; ai < 2; ++ai)
#pragma unroll
            for (int m = 0; m < 4; ++m) { bf16_t* rowp = O + (size_t)(row0 + ai * HALF + m * 16) * ldc + col0;
#pragma unroll
                for (int bj = 0; bj < 2; ++bj) { const f32x4 v0 = acc[ai][bj][m][0], v1 = acc[ai][bj][m][1];
                    u32x4 w; w.x = cvt_pk_bf16(v0[0], v0[1]); w.y = cvt_pk_bf16(v0[2], v0[3]); w.z = cvt_pk_bf16(v1[0], v1[1]); w.w = cvt_pk_bf16(v1[2], v1[3]);
                    *(u32x4*)(rowp + bj * HALF) = w; } }
    }
};
struct EpiMerge {
    static constexpr bool PERM = true, AFTER_DRAIN = false; static constexpr int MIDK = 32;
    const bf16_t *GA, *GB; bf16_t* O;
    __device__ __forceinline__ void mid(f32x4 (&acc)[2][2][4][2], const Unit& u, int wr, int wc, int fr, int fq) const {
        int row0 = u.pm * BM + wr * 64 + fr; const int col0 = u.pn * BM + wc * 32 + 8 * fq;
        asm volatile("" : "+v"(row0));
#pragma unroll
        for (int ai = 0; ai < 2; ++ai)
#pragma unroll
            for (int m = 0; m < 4; ++m) { const size_t off = (size_t)(row0 + ai * HALF + m * 16) * 2048 + col0;
#pragma unroll
                for (int bj = 0; bj < 2; ++bj) { const u32x4 a = *(const u32x4*)(GA + off + bj * HALF), b = *(const u32x4*)(GB + off + bj * HALF);
                    f32x4 r0, r1;
                    r0[0] = bf_lo(a.x) * __builtin_amdgcn_rcpf(bf_lo(b.x)); r0[1] = bf_hi(a.x) * __builtin_amdgcn_rcpf(bf_hi(b.x));
                    r0[2] = bf_lo(a.y) * __builtin_amdgcn_rcpf(bf_lo(b.y)); r0[3] = bf_hi(a.y) * __builtin_amdgcn_rcpf(bf_hi(b.y));
                    r1[0] = bf_lo(a.z) * __builtin_amdgcn_rcpf(bf_lo(b.z)); r1[1] = bf_hi(a.z) * __builtin_amdgcn_rcpf(bf_hi(b.z));
                    r1[2] = bf_lo(a.w) * __builtin_amdgcn_rcpf(bf_lo(b.w)); r1[3] = bf_hi(a.w) * __builtin_amdgcn_rcpf(bf_hi(b.w));
                    acc[ai][bj][m][0] *= r0; acc[ai][bj][m][1] *= r1; }
                asm volatile("" ::: "memory"); }
    }
    __device__ __forceinline__ void operator()(const f32x4 (&acc)[2][2][4][2], const Unit& u, int wr, int wc, int fr, int fq) const {
        int row0 = u.pm * BM + wr * 64 + fr; const int col0 = u.pn * BM + wc * 32 + 8 * fq;
        asm volatile("" : "+v"(row0));
#pragma unroll
        for (int ai = 0; ai < 2; ++ai)
#pragma unroll
            for (int m = 0; m < 4; ++m) { const size_t off = (size_t)(row0 + ai * HALF + m * 16) * 2048 + col0;
#pragma unroll
                for (int bj = 0; bj < 2; ++bj) { const u32x4 b = *(const u32x4*)(GB + off + bj * HALF); const f32x4 v0 = acc[ai][bj][m][0], v1 = acc[ai][bj][m][1];
                    u32x4 w; w.x = cvt_pk_bf16(v0[0] * bf_lo(b.x), v0[1] * bf_hi(b.x)); w.y = cvt_pk_bf16(v0[2] * bf_lo(b.y), v0[3] * bf_hi(b.y));
                    w.z = cvt_pk_bf16(v1[0] * bf_lo(b.z), v1[1] * bf_hi(b.z)); w.w = cvt_pk_bf16(v1[2] * bf_lo(b.w), v1[3] * bf_hi(b.w));
                    *(u32x4*)(O + off + bj * HALF) = w; }
                asm volatile("" ::: "memory"); }
    }
};
struct EpiF32 {
    static constexpr bool PERM = false, AFTER_DRAIN = false; static constexpr int MIDK = 0;
    float* C; int ldc;
    __device__ __forceinline__ void mid(f32x4 (&)[2][2][4][2], const Unit&, int, int, int, int) const {}
    __device__ __forceinline__ void operator()(const f32x4 (&acc)[2][2][4][2], const Unit& u, int wr, int wc, int fr, int fq) const {
        const int row0 = u.pm * BM + wr * 64 + fr, col0 = u.pn * BM + wc * 32 + 4 * fq;
#pragma unroll
        for (int ai = 0; ai < 2; ++ai)
#pragma unroll
            for (int m = 0; m < 4; ++m) { float* rowp = C + (size_t)(row0 + ai * HALF + m * 16) * ldc + col0;
#pragma unroll
                for (int bj = 0; bj < 2; ++bj)
#pragma unroll
                    for (int n = 0; n < 2; ++n) *(f32x4*)(rowp + bj * HALF + n * 16) = acc[ai][bj][m][n]; }
    }
};

constexpr int UPF = 5632, UPF2 = 11264;
template <int CTRL> __device__ __forceinline__ float dpp_mov(float old, float src) {
    return __builtin_bit_cast(float, __builtin_amdgcn_update_dpp(__builtin_bit_cast(int, old), __builtin_bit_cast(int, src), CTRL, 0xF, 0xF, false)); }
template <int CTRL> __device__ __forceinline__ float dpp_rot(float src) {
    return __builtin_bit_cast(float, __builtin_amdgcn_mov_dpp(__builtin_bit_cast(int, src), CTRL, 0xF, 0xF, false)); }
struct EpiUpConv {
    static constexpr bool PERM = true, AFTER_DRAIN = false; static constexpr int MIDK = 0;
    bf16_t* ACT; float* RAWB; const float* cw; const float* cb; PG8_LAS unsigned char* xch;
    __device__ __forceinline__ void mid(f32x4 (&)[2][2][4][2], const Unit&, int, int, int, int) const {}
    __device__ __forceinline__ void operator()(const f32x4 (&acc)[2][2][4][2], const Unit& u, int wr, int wc, int fr, int fq) const {
        const int colh = 32 * wc + 8 * fq; int ca = u.pn * HALF + colh;
        asm volatile("" : "+v"(ca));
        PG8_LAS float* X = (PG8_LAS float*)xch;
#pragma unroll
        for (int ai = 0; ai < 2; ++ai) { const int s = 2 * ai + wr;
            if (fr >= 14) {
                if (s < 3) {
#pragma unroll
                    for (int bj = 0; bj < 2; ++bj)
#pragma unroll
                        for (int n = 0; n < 2; ++n) *(PG8_LAS f32x4*)(X + ((s * 2 + (fr - 14)) * 256 + bj * HALF + colh + 4 * n)) = acc[ai][bj][3][n];
                } else {
#pragma unroll
                    for (int bj = 0; bj < 2; ++bj)
#pragma unroll
                        for (int n = 0; n < 2; ++n) *(f32x4*)(RAWB + ((size_t)(u.pm * 4 + 2 + (fr - 14)) * UPF2 + bj * UPF + ca + 4 * n)) = acc[ai][bj][3][n];
                } } }
        if (wr == 0 && fr < 2) {
#pragma unroll
            for (int bj = 0; bj < 2; ++bj)
#pragma unroll
                for (int n = 0; n < 2; ++n) *(f32x4*)(RAWB + ((size_t)(u.pm * 4 + fr) * UPF2 + bj * UPF + ca + 4 * n)) = acc[0][bj][0][n]; }
        asm volatile("s_waitcnt lgkmcnt(0)" ::: "memory"); __builtin_amdgcn_s_barrier(); asm volatile("" ::: "memory");
        f32x4 w0[2][2], w1[2][2], w2[2][2], bb[2][2];
#pragma unroll
        for (int bj = 0; bj < 2; ++bj)
#pragma unroll
            for (int n = 0; n < 2; ++n) { const float* pc = cw + bj * UPF + ca + 4 * n; w0[bj][n] = *(const f32x4*)pc; w1[bj][n] = *(const f32x4*)(pc + UPF2); w2[bj][n] = *(const f32x4*)(pc + 2 * UPF2);
                bb[bj][n] = *(const f32x4*)(cb + bj * UPF + ca + 4 * n); }
#pragma unroll
        for (int ai = 0; ai < 2; ++ai) {
            f32x4 pv[2][2]; const int sp = 2 * ai + wr - 1;
#pragma unroll
            for (int bj = 0; bj < 2; ++bj)
#pragma unroll
                for (int n = 0; n < 2; ++n) pv[bj][n] = (sp >= 0) ? *(const PG8_LAS f32x4*)(X + ((sp * 2 + (fr & 1)) * 256 + bj * HALF + colh + 4 * n)) : (f32x4){0.f, 0.f, 0.f, 0.f};
#pragma unroll
            for (int m = 0; m < 4; ++m) {
                f32x4 cv[2][2];
#pragma unroll
                for (int bj = 0; bj < 2; ++bj)
#pragma unroll
                    for (int n = 0; n < 2; ++n) { const f32x4 v = acc[ai][bj][m][n]; const f32x4 pp = (m == 0) ? pv[bj][n] : acc[ai][bj][m > 0 ? m - 1 : 0][n]; f32x4 p1, p2;
#pragma unroll
                        for (int j = 0; j < 4; ++j) { p1[j] = dpp_mov<0x111>(dpp_rot<0x121>(pp[j]), v[j]); p2[j] = dpp_mov<0x112>(dpp_rot<0x122>(pp[j]), v[j]); }
                        cv[bj][n] = bb[bj][n] + w0[bj][n] * p2 + w1[bj][n] * p1 + w2[bj][n] * v; }
                const f32x4 o0 = gelu_v4(cv[0][0]) * cv[1][0], o1 = gelu_v4(cv[0][1]) * cv[1][1];
                u32x4 w; w.x = cvt_pk_bf16(o0[0], o0[1]); w.y = cvt_pk_bf16(o0[2], o0[3]); w.z = cvt_pk_bf16(o1[0], o1[1]); w.w = cvt_pk_bf16(o1[2], o1[3]);
                const int row = u.pm * BM + ai * HALF + wr * 64 + m * 16 + fr;
                if (!(ai == 0 && m == 0 && wr == 0 && fr < 2)) *(u32x4*)(ACT + (size_t)row * UPF + ca) = w;
            }
        }
    }
};
struct FixOrder : StaticOrder {
    bf16_t* ACT; const float* RAWB; const float* cw; const float* cb;
    __device__ __forceinline__ void a_ready(const Unit& u) const {
        for (int ch = threadIdx.x; ch < 2 * (UPF / 8); ch += 512) { const int r = ch / (UPF / 8), q8 = (ch % (UPF / 8)) * 8;
            f32x4 a0 = *(const f32x4*)(cb + q8), a1 = *(const f32x4*)(cb + q8 + 4), g0 = *(const f32x4*)(cb + UPF + q8), g1 = *(const f32x4*)(cb + UPF + q8 + 4);
#pragma unroll
            for (int k = 0; k < 3; ++k) { const int rr = r - 2 + k;
                if (rr >= 0 || u.pm > 0) { const float* src = RAWB + (size_t)(rr >= 0 ? u.pm * 4 + rr : (u.pm - 1) * 4 + 4 + rr) * UPF2; const float* wk = cw + k * UPF2;
                    a0 += *(const f32x4*)(wk + q8) * *(const f32x4*)(src + q8); a1 += *(const f32x4*)(wk + q8 + 4) * *(const f32x4*)(src + q8 + 4);
                    g0 += *(const f32x4*)(wk + UPF + q8) * *(const f32x4*)(src + UPF + q8); g1 += *(const f32x4*)(wk + UPF + q8 + 4) * *(const f32x4*)(src + UPF + q8 + 4); } }
            u32x4 w; w.x = cvt_pk_bf16(gelu_tanh_f(a0[0]) * g0[0], gelu_tanh_f(a0[1]) * g0[1]); w.y = cvt_pk_bf16(gelu_tanh_f(a0[2]) * g0[2], gelu_tanh_f(a0[3]) * g0[3]);
            w.z = cvt_pk_bf16(gelu_tanh_f(a1[0]) * g1[0], gelu_tanh_f(a1[1]) * g1[1]); w.w = cvt_pk_bf16(gelu_tanh_f(a1[2]) * g1[2], gelu_tanh_f(a1[3]) * g1[3]);
            *(u32x4*)(ACT + (size_t)(u.pm * BM + r) * UPF + q8) = w; }
        asm volatile("s_waitcnt vmcnt(0)" ::: "memory"); __builtin_amdgcn_s_barrier(); asm volatile("" ::: "memory");
    }
};

struct PanelSS {
    unsigned* xbuf;
    unsigned* cnt;
    unsigned* tmo;
    float eps;
    __device__ __forceinline__ void run(const f32x4 (&v)[2][2][4][2], const Unit& u, int wr, int wc, int fr, int fq, PG8_LAS unsigned char* lds, int wid, int lane) const {
        PG8_LAS float* P = (PG8_LAS float*)lds;
        PG8_LAS float* S = (PG8_LAS float*)(lds + 8192);
#pragma unroll
        for (int ai = 0; ai < 2; ++ai)
#pragma unroll
            for (int m = 0; m < 4; ++m) { float q = 0.f;
#pragma unroll
                for (int bj = 0; bj < 2; ++bj)
#pragma unroll
                    for (int n = 0; n < 2; ++n) { const f32x4 x = v[ai][bj][m][n]; q += (x[0] * x[0] + x[1] * x[1]) + (x[2] * x[2] + x[3] * x[3]); }
                q += __shfl_xor(q, 16); q += __shfl_xor(q, 32);
                if (fq == 0) P[(ai * HALF + wr * 64 + m * 16 + fr) * 4 + wc] = q; }
        asm volatile("s_waitcnt lgkmcnt(0)" ::: "memory"); __builtin_amdgcn_s_barrier(); asm volatile("" ::: "memory");
        const int row = wid * 32 + (lane & 31);
        if (lane < 32) { const float q = (P[row * 4 + 0] + P[row * 4 + 1]) + (P[row * 4 + 2] + P[row * 4 + 3]);
            __hip_atomic_store(xbuf + ((size_t)(u.pm * BM + row) * 8 + u.pn), __builtin_bit_cast(unsigned, q), __ATOMIC_RELAXED, __HIP_MEMORY_SCOPE_AGENT); }
        asm volatile("s_waitcnt vmcnt(0)" ::: "memory");
        if (lane == 0) __hip_atomic_fetch_add(cnt + 64 * u.pm, 1u, __ATOMIC_RELAXED, __HIP_MEMORY_SCOPE_AGENT);
        if (wid == 0) {
            unsigned sp = 0;
            while ((unsigned)__builtin_amdgcn_readfirstlane(__hip_atomic_load(cnt + 64 * u.pm, __ATOMIC_RELAXED, __HIP_MEMORY_SCOPE_AGENT)) < 64u) {
                __builtin_amdgcn_s_sleep(2);
                if (++sp > (1u << 20)) { if (lane == 0) __hip_atomic_store(tmo, 1u, __ATOMIC_RELAXED, __HIP_MEMORY_SCOPE_AGENT); break; } }
            __builtin_amdgcn_fence(__ATOMIC_ACQUIRE, "agent");
        }
        asm volatile("s_waitcnt vmcnt(0) lgkmcnt(0)" ::: "memory"); __builtin_amdgcn_s_barrier(); asm volatile("" ::: "memory");
        if (lane < 32) { const unsigned* slot = xbuf + (size_t)(u.pm * BM + row) * 8; float q = 0.f;
#pragma unroll
            for (int t = 0; t < 8; ++t) q += __builtin_bit_cast(float, __hip_atomic_load(slot + t, __ATOMIC_RELAXED, __HIP_MEMORY_SCOPE_AGENT));
            S[row] = 1.0f / sqrtf(q * (1.0f / 2048.0f) + eps); }
        asm volatile("s_waitcnt lgkmcnt(0)" ::: "memory"); __builtin_amdgcn_s_barrier(); asm volatile("" ::: "memory");
    }
};
struct EpiMixFused {
    static constexpr bool PERM = true, AFTER_DRAIN = true; static constexpr int MIDK = 0;
    const float* x; bf16_t* X1B; bf16_t* H2; const float* vec; PanelSS st1, st2;
    __device__ __forceinline__ void mid(f32x4 (&)[2][2][4][2], const Unit&, int, int, int, int) const {}
    __device__ __forceinline__ void operator()(const f32x4 (&)[2][2][4][2], const Unit&, int, int, int, int) const {}
    __device__ __forceinline__ void fused(f32x4 (&acc)[2][2][4][2], const Unit& u, int wr, int wc, int fr, int fq, PG8_LAS unsigned char* lds, int wid, int lane) const {
        const PG8_LAS float* S = (const PG8_LAS float*)(lds + 8192);
        const int col0 = u.pn * BM + wc * 32 + 8 * fq;
        st1.run(acc, u, wr, wc, fr, fq, lds, wid, lane);
        { f32x4 g1[2][2];
#pragma unroll
          for (int bj = 0; bj < 2; ++bj)
#pragma unroll
            for (int n = 0; n < 2; ++n) g1[bj][n] = *(const f32x4*)(vec + col0 + bj * HALF + n * 4);
#pragma unroll
          for (int ai = 0; ai < 2; ++ai)
#pragma unroll
            for (int m = 0; m < 4; ++m) { const int r = ai * HALF + wr * 64 + m * 16 + fr; const float rs = S[r]; const size_t off = (size_t)(u.pm * BM + r) * 2048 + col0;
#pragma unroll
                for (int bj = 0; bj < 2; ++bj) { const f32x4 xa = __builtin_nontemporal_load((const f32x4*)(x + off + bj * HALF)), xb = __builtin_nontemporal_load((const f32x4*)(x + off + bj * HALF + 4));
                    const f32x4 x1a = xa + g1[bj][0] * (acc[ai][bj][m][0] * rs), x1b = xb + g1[bj][1] * (acc[ai][bj][m][1] * rs);
                    acc[ai][bj][m][0] = x1a; acc[ai][bj][m][1] = x1b;
                    u32x4 o; o.x = cvt_pk_bf16(x1a[0], x1a[1]); o.y = cvt_pk_bf16(x1a[2], x1a[3]); o.z = cvt_pk_bf16(x1b[0], x1b[1]); o.w = cvt_pk_bf16(x1b[2], x1b[3]);
                    *(u32x4*)(X1B + off + bj * HALF) = o; }
                asm volatile("" ::: "memory"); } }
        st2.run(acc, u, wr, wc, fr, fq, lds, wid, lane);
        { f32x4 a2[2][2], b2[2][2];
#pragma unroll
          for (int bj = 0; bj < 2; ++bj)
#pragma unroll
            for (int n = 0; n < 2; ++n) { a2[bj][n] = *(const f32x4*)(vec + 2048 + col0 + bj * HALF + n * 4); b2[bj][n] = *(const f32x4*)(vec + 4096 + col0 + bj * HALF + n * 4); }
#pragma unroll
          for (int ai = 0; ai < 2; ++ai)
#pragma unroll
            for (int m = 0; m < 4; ++m) { const int r = ai * HALF + wr * 64 + m * 16 + fr; const float rs = S[r]; const size_t off = (size_t)(u.pm * BM + r) * 2048 + col0;
#pragma unroll
                for (int bj = 0; bj < 2; ++bj) { const f32x4 ha = acc[ai][bj][m][0] * rs * a2[bj][0] + b2[bj][0], hb = acc[ai][bj][m][1] * rs * a2[bj][1] + b2[bj][1];
                    u32x4 o; o.x = cvt_pk_bf16(ha[0], ha[1]); o.y = cvt_pk_bf16(ha[2], ha[3]); o.z = cvt_pk_bf16(hb[0], hb[1]); o.w = cvt_pk_bf16(hb[2], hb[3]);
                    *(u32x4*)(H2 + off + bj * HALF) = o; } } }
    }
};
struct EpiOutFused {
    static constexpr bool PERM = true, AFTER_DRAIN = true; static constexpr int MIDK = 0;
    const bf16_t* X1B; float* out; const float* vec; PanelSS st;
    __device__ __forceinline__ void mid(f32x4 (&)[2][2][4][2], const Unit&, int, int, int, int) const {}
    __device__ __forceinline__ void operator()(const f32x4 (&)[2][2][4][2], const Unit&, int, int, int, int) const {}
    __device__ __forceinline__ void fused(f32x4 (&acc)[2][2][4][2], const Unit& u, int wr, int wc, int fr, int fq, PG8_LAS unsigned char* lds, int wid, int lane) const {
        const PG8_LAS float* S = (const PG8_LAS float*)(lds + 8192);
        const int col0 = u.pn * BM + wc * 32 + 8 * fq;
        st.run(acc, u, wr, wc, fr, fq, lds, wid, lane);
        f32x4 g2[2][2];
#pragma unroll
        for (int bj = 0; bj < 2; ++bj)
#pragma unroll
            for (int n = 0; n < 2; ++n) g2[bj][n] = *(const f32x4*)(vec + 3 * 2048 + col0 + bj * HALF + n * 4);
#pragma unroll
        for (int ai = 0; ai < 2; ++ai)
#pragma unroll
            for (int m = 0; m < 4; ++m) { const int r = ai * HALF + wr * 64 + m * 16 + fr; const float rs = S[r]; const size_t off = (size_t)(u.pm * BM + r) * 2048 + col0;
#pragma unroll
                for (int bj = 0; bj < 2; ++bj) { const u32x4 xb = __builtin_nontemporal_load((const u32x4*)(X1B + off + bj * HALF));
                    const f32x4 xa = (f32x4){bf_lo(xb.x), bf_hi(xb.x), bf_lo(xb.y), bf_hi(xb.y)}, xc = (f32x4){bf_lo(xb.z), bf_hi(xb.z), bf_lo(xb.w), bf_hi(xb.w)};
                    __builtin_nontemporal_store(xa + g2[bj][0] * (acc[ai][bj][m][0] * rs), (f32x4*)(out + off + bj * HALF)); __builtin_nontemporal_store(xc + g2[bj][1] * (acc[ai][bj][m][1] * rs), (f32x4*)(out + off + bj * HALF + 4)); }
                asm volatile("" ::: "memory"); }
    }
};

template <class Epi, class Sched, bool ALIGN_EPI = false, bool SP2 = false, int EPI_S = 0>
__device__ __forceinline__ void gemm_phase(PG8_LAS unsigned char* lds, const Gemm g, const Sched& S, const Epi& E) {
    const int tid = threadIdx.x, wid = __builtin_amdgcn_readfirstlane(tid >> 6), lane = tid & 63, wr = wid >> 2, wc = wid & 3, fr = lane & 15, fq = lane >> 4;
    const int K = g.K, nt = K / BK;
    unsigned voffA[2], voffB[2];
#pragma unroll
    for (int i = 0; i < 2; ++i) { int R, C; stage_rc(tid * 16 + i * 8192, R, C); const int Rb = Epi::PERM ? ((R & ~31) + perm32(R & 31)) : R;
        voffA[i] = (unsigned)(R * K + C) * 2u; voffB[i] = (unsigned)(Rb * K + C) * 2u; }
    const size_t kstep = (size_t)(BK * 2);
    const size_t hstep = (size_t)HALF * K * 2;
    const size_t tstep = 2 * hstep;
    const size_t hstepB = g.b_hstep ? g.b_hstep : hstep, tstepB = g.b_tstep ? g.b_tstep : tstep;
    const unsigned ldsw = (unsigned)wid * 1024u;
    const int aoff = lds_byte(wr * 64 + fr, fq * 8), boff = lds_byte(wc * 32 + fr, fq * 8);
#define PG8_SA(b, h) (((b) * 2 + (h)) * HTB)
#define PG8_SB(b, h) ((4 + (b) * 2 + (h)) * HTB)
#define PG8_STAGE(bufoff, gbase, voff) do { _Pragma("unroll") for (int _i = 0; _i < 2; ++_i) \
        __builtin_amdgcn_raw_ptr_buffer_load_lds((&(voff)[0] == &voffA[0]) ? rsA : rsB, (PG8_LAS void*)(lds + (bufoff) + ldsw + _i * 8192), 16, (int)(voff)[_i], (int)(gbase), 0, 0); } while (0)
#define PG8_LDA(dst, b, h) do { _Pragma("unroll") for (int m = 0; m < 4; ++m) _Pragma("unroll") for (int k = 0; k < 2; ++k) dst[m][k] = *(const PG8_LAS bf16x8*)(lds + PG8_SA(b, h) + aoff + m * 2048 + k * 1024); } while (0)
#define PG8_LDB(dst, b, h) do { _Pragma("unroll") for (int n = 0; n < 2; ++n) _Pragma("unroll") for (int k = 0; k < 2; ++k) dst[n][k] = *(const PG8_LAS bf16x8*)(lds + PG8_SB(b, h) + boff + n * 2048 + k * 1024); } while (0)
#define PG8_MMA(ai, bj, At, Bt) do { __builtin_amdgcn_s_setprio(1); _Pragma("unroll") for (int m = 0; m < 4; ++m) _Pragma("unroll") for (int n = 0; n < 2; ++n) _Pragma("unroll") for (int k = 0; k < 2; ++k) \
        acc[ai][bj][m][n] = __builtin_amdgcn_mfma_f32_16x16x32_bf16(Bt[n][k], At[m][k], acc[ai][bj][m][n], 0, 0, 0); __builtin_amdgcn_s_setprio(0); } while (0)
#define PG8_WAIT_V(n) asm volatile("s_waitcnt vmcnt(" #n ")" ::: "memory")
#define PG8_WAIT_VN(n) asm volatile("s_waitcnt vmcnt(%0)" :: "i"(n) : "memory")
#define PG8_WAIT_L(n) asm volatile("s_waitcnt lgkmcnt(" #n ")" ::: "memory")
#define PG8_BAR __builtin_amdgcn_s_barrier()
#define PG8_SCHED __builtin_amdgcn_sched_barrier(0)
    Unit cur, nxt; int ui = 0;
    [[maybe_unused]] bool fa = false;
    if (!S.next(0, cur)) return;
    f32x4 acc[2][2][4][2];
#pragma unroll
    for (int a = 0; a < 2; ++a)
#pragma unroll
        for (int b = 0; b < 2; ++b)
#pragma unroll
            for (int m = 0; m < 4; ++m)
#pragma unroll
                for (int n = 0; n < 2; ++n) acc[a][b][m][n] = (f32x4){0.f, 0.f, 0.f, 0.f};
    bf16x8 At[4][2], B0[2][2], B1[2][2];
    const __amdgpu_buffer_rsrc_t rsA = __builtin_amdgcn_make_buffer_rsrc((void*)g.A, 0, (int)((size_t)g.M * K * 2), 0x00020000), rsB = __builtin_amdgcn_make_buffer_rsrc((void*)g.Bt, 0, (int)((size_t)g.N * K * 2), 0x00020000);
    unsigned cA = (unsigned)((size_t)cur.pm * tstep), cB = (unsigned)((size_t)cur.pn * tstepB);
    S.a_ready(cur);
    if constexpr (SP2) {
        PG8_STAGE(PG8_SB(0, 0), cB, voffB); PG8_STAGE(PG8_SB(0, 1), cB + hstepB, voffB); PG8_STAGE(PG8_SA(0, 0), cA, voffA); PG8_STAGE(PG8_SA(0, 1), cA + hstep, voffA);
        if (wr == 1) PG8_BAR;
        PG8_WAIT_V(2); PG8_BAR;
        PG8_STAGE(PG8_SB(1, 0), cB + kstep, voffB); PG8_STAGE(PG8_SB(1, 1), cB + hstepB + kstep, voffB);
        PG8_WAIT_V(6); PG8_BAR;
    } else {
        PG8_STAGE(PG8_SB(0, 0), cB, voffB); PG8_STAGE(PG8_SA(0, 0), cA, voffA); PG8_STAGE(PG8_SB(0, 1), cB + hstepB, voffB); PG8_STAGE(PG8_SA(0, 1), cA + hstep, voffA);
        if (wr == 1) PG8_BAR;
        PG8_WAIT_V(4); PG8_BAR;
        PG8_STAGE(PG8_SB(1, 0), cB + kstep, voffB); PG8_STAGE(PG8_SA(1, 0), cA + kstep, voffA); PG8_STAGE(PG8_SB(1, 1), cB + hstepB + kstep, voffB);
        PG8_WAIT_V(6); PG8_BAR;
    }
    for (;;) {
        const bool has_next = S.next(ui + 1, nxt);
        const unsigned nA = has_next ? (unsigned)((size_t)nxt.pm * tstep) : cA, nB = has_next ? (unsigned)((size_t)nxt.pn * tstepB) : cB;
        for (int tb = 0; tb < nt; ) {
        const int te = (Epi::MIDK > 0 && tb < Epi::MIDK) ? Epi::MIDK : nt;
        if constexpr (Epi::MIDK > 0) { if (tb == Epi::MIDK) E.mid(acc, cur, wr, wc, fr, fq); }
#define PG8_KBODY(V1, V2, V3, DO_A1) { \
            const bool last = (t == nt - 2); \
            const unsigned a1 = cA + (unsigned)((t + 1) * kstep); \
            const unsigned a2 = last ? nA : cA + (unsigned)((t + 2) * kstep), b2 = last ? nB : cB + (unsigned)((t + 2) * kstep); \
            const unsigned b3 = b2 + (unsigned)kstep; \
            if (last && has_next) S.a_ready(nxt); \
              \
            PG8_LDB(B0, 0, 0); PG8_LDB(B1, 0, 1); PG8_SCHED; PG8_LDA(At, 0, 0); if (DO_A1) { PG8_STAGE(PG8_SA(1, 0), a1, voffA); PG8_STAGE(PG8_SA(1, 1), a1 + hstep, voffA); } \
            PG8_WAIT_VN(V1); PG8_WAIT_L(0); PG8_BAR; PG8_MMA(0, 0, At, B0); PG8_MMA(0, 1, At, B1); PG8_BAR; PG8_SCHED; \
              \
            PG8_LDA(At, 0, 1); PG8_STAGE(PG8_SB(0, 0), b2, voffB); PG8_STAGE(PG8_SB(0, 1), b2 + hstepB, voffB); \
            PG8_WAIT_VN(V2); PG8_WAIT_L(0); PG8_BAR; PG8_MMA(1, 0, At, B0); PG8_MMA(1, 1, At, B1); PG8_BAR; PG8_SCHED; \
              \
            PG8_LDB(B0, 1, 0); PG8_LDB(B1, 1, 1); PG8_SCHED; PG8_LDA(At, 1, 0); PG8_STAGE(PG8_SA(0, 0), a2, voffA); PG8_STAGE(PG8_SA(0, 1), a2 + hstep, voffA); \
            PG8_WAIT_VN(V3); PG8_WAIT_L(0); PG8_BAR; PG8_MMA(0, 0, At, B0); PG8_MMA(0, 1, At, B1); PG8_BAR; PG8_SCHED; \
              \
            PG8_LDA(At, 1, 1); PG8_STAGE(PG8_SB(1, 0), b3, voffB); PG8_STAGE(PG8_SB(1, 1), b3 + hstepB, voffB); \
            PG8_WAIT_VN(6); PG8_WAIT_L(0); PG8_BAR; PG8_MMA(1, 0, At, B0); PG8_MMA(1, 1, At, B1); PG8_BAR; PG8_SCHED; }
        static_assert(SP2, "this body keeps only the two-super-phase K-loop");
        int t = tb;
        if constexpr (EPI_S > 0) { if (fa && t == 0 && te >= 2) { PG8_KBODY(8 + EPI_S, 6 + EPI_S, 8 + EPI_S, false); t = 2; } }
        for (; t < te; t += 2) PG8_KBODY(8, 6, 8, true);
        tb = te; }
        if constexpr (ALIGN_EPI) { if (wr == 0) PG8_BAR; }
        if constexpr (EPI_S > 0 && ALIGN_EPI) { fa = has_next; if (has_next) { PG8_STAGE(PG8_SA(1, 0), nA + kstep, voffA); PG8_STAGE(PG8_SA(1, 1), nA + kstep + hstep, voffA); PG8_WAIT_VN(4); } }
        if constexpr (!Epi::AFTER_DRAIN) { E(acc, cur, wr, wc, fr, fq); S.done(cur); }
        if (!has_next) break;
#pragma unroll
        for (int a = 0; a < 2; ++a)
#pragma unroll
            for (int b = 0; b < 2; ++b)
#pragma unroll
                for (int m = 0; m < 4; ++m)
#pragma unroll
                    for (int n = 0; n < 2; ++n) acc[a][b][m][n] = (f32x4){0.f, 0.f, 0.f, 0.f};
        cur = nxt; cA = nA; cB = nB; ++ui;
        if constexpr (ALIGN_EPI) { if (wr == 1) PG8_BAR; }
    }
    PG8_WAIT_V(0);
    if constexpr (!ALIGN_EPI) { if (wr == 0) PG8_BAR; }
    PG8_BAR;
    if constexpr (Epi::AFTER_DRAIN) { E.fused(acc, cur, wr, wc, fr, fq, lds, wid, lane); S.done(cur); }
#undef PG8_SA
#undef PG8_SB
#undef PG8_STAGE
#undef PG8_LDA
#undef PG8_LDB
#undef PG8_MMA
#undef PG8_WAIT_VN
#undef PG8_KBODY
#undef PG8_WAIT_V
#undef PG8_WAIT_L
#undef PG8_BAR
#undef PG8_SCHED
}
}
#define GAS __attribute__((address_space(1)))
#define LAS __attribute__((address_space(3)))
typedef unsigned short bf16;
typedef unsigned v4u __attribute__((ext_vector_type(4)));
typedef float f32x4 __attribute__((ext_vector_type(4)));
typedef short bf16x8 __attribute__((ext_vector_type(8)));
typedef GAS unsigned gu32;
typedef GAS unsigned long long gu64;
#define RLX_AGENT __ATOMIC_RELAXED, __HIP_MEMORY_SCOPE_AGENT
#define LDS_WAIT() asm volatile("s_waitcnt lgkmcnt(0)" ::: "memory")
#define VM_WAIT() asm volatile("s_waitcnt vmcnt(0)" ::: "memory")
__device__ __forceinline__ unsigned long long rt() { return __builtin_amdgcn_s_memrealtime(); }
__device__ __forceinline__ unsigned f2bf(float f) { unsigned u = __builtin_bit_cast(unsigned, f); return (u + 0x7fffu + ((u >> 16) & 1u)) >> 16; }
__device__ __forceinline__ unsigned pk2(float lo, float hi) { return f2bf(lo) | (f2bf(hi) << 16); }

#define XB_TMO      128
#define XB_XCNT(j)  (256  + 64 * (j))
#define XB_XSUB(j)  (1280 + 64 * (j))
#define XB_XGEN(j)  (2304 + 64 * (j))
#define XB_TOP      3328
#define XB_TOPGEN   3392
#define XCD_BAR_WORDS 3456
#define XB_SPIN_CAP (1u << 18)

__device__ __forceinline__ unsigned xb_ld(unsigned* p)              { return __hip_atomic_load(p, __ATOMIC_RELAXED, __HIP_MEMORY_SCOPE_AGENT); }
__device__ __forceinline__ unsigned xb_add(unsigned* p, unsigned v) { return __hip_atomic_fetch_add(p, v, __ATOMIC_RELAXED, __HIP_MEMORY_SCOPE_AGENT); }
__device__ __forceinline__ unsigned xb_xcc_id() { return (unsigned)__builtin_amdgcn_s_getreg((3 << 11) | 20) & 0xFu; }
#define XB_SPIN(cond, bar) do { unsigned _sp = 0; while (cond) { __builtin_amdgcn_s_sleep(1); \
    if ((++_sp & 255u) == 0u) { if (xb_ld(&(bar)[XB_TMO])) break; if (_sp > XB_SPIN_CAP) { atomicAdd(&(bar)[XB_TMO], 1u); break; } } } } while (0)

struct XcdBarrier {
    unsigned* bar; unsigned x;
    volatile LAS unsigned* st;
};

__device__ __forceinline__ XcdBarrier xcd_barrier_post(unsigned* bar, volatile LAS unsigned* st) {
    XcdBarrier b; b.bar = bar; b.x = xb_xcc_id(); b.st = st;
    if (threadIdx.x == 0) (void)xb_add(&bar[XB_XCNT(b.x)], 1u);
    return b;
}
__device__ __forceinline__ void xcd_barrier_complete(unsigned* bar, unsigned x, unsigned& nloc, unsigned& nx) {
    const unsigned G = gridDim.x * gridDim.y * gridDim.z;
    unsigned sum, cnt, mine, sp = 0u;
    for (;;) {
        sum = 0u; cnt = 0u; mine = 0u;
#pragma unroll
        for (unsigned j = 0; j < 16; ++j) { const unsigned c = xb_ld(&bar[XB_XCNT(j)]); sum += c; cnt += (c > 0u) ? 1u : 0u; mine = (j == x) ? c : mine; }
        if (sum == G) break;
        __builtin_amdgcn_s_sleep(1);
        if ((++sp & 255u) == 0u) { if (xb_ld(&bar[XB_TMO])) break; if (sp > XB_SPIN_CAP) { atomicAdd(&bar[XB_TMO], 1u); break; } }
    }
    nloc = mine > 0u ? mine : 1u; nx = cnt > 0u ? cnt : 1u;
}

__device__ __forceinline__ void xcd_barrier(const XcdBarrier& b) {
    asm volatile("s_waitcnt vmcnt(0)" ::: "memory");
    __syncthreads();
    if (threadIdx.x == 0) {
        unsigned* bar = b.bar;
        __builtin_amdgcn_s_waitcnt(0);
        unsigned nloc = b.st[0], nx = b.st[1];
        if (nloc == 0u) { xcd_barrier_complete(bar, b.x, nloc, nx); b.st[0] = nloc; b.st[1] = nx; }
        const unsigned old = xb_add(&bar[XB_XSUB(b.x)], 1u);
        const unsigned gen = old / nloc;
        if (old + 1u == (gen + 1u) * nloc) {
            __builtin_amdgcn_fence(__ATOMIC_RELEASE, "agent");
            asm volatile("s_waitcnt vmcnt(0)" ::: "memory");
            const unsigned og = xb_add(&bar[XB_TOP], 1u);
            const unsigned tg = og / nx;
            if (og + 1u == (tg + 1u) * nx) xb_add(&bar[XB_TOPGEN], 1u);
            else XB_SPIN(xb_ld(&bar[XB_TOPGEN]) == tg, bar);
            __builtin_amdgcn_fence(__ATOMIC_ACQUIRE, "agent");
            xb_add(&bar[XB_XGEN(b.x)], 1u);
            asm volatile("s_waitcnt vmcnt(0)" ::: "memory");
        } else {
            XB_SPIN(xb_ld(&bar[XB_XGEN(b.x)]) == gen, bar);
            __builtin_amdgcn_fence(__ATOMIC_ACQUIRE, "agent");
            asm volatile("s_waitcnt vmcnt(0)" ::: "memory");
        }
    }
    __syncthreads();
}

#ifndef MK_N_LAUNCHES
#define MK_N_LAUNCHES 1
#endif
constexpr int NWAVES = 8, NPHASES = 10;
constexpr int N_LAUNCHES = MK_N_LAUNCHES;
constexpr int SEQ = 8192, DM = 2048, AW = 2048, BW = 1024, INC = 9216, FF = 5632, FF2 = 11264, NMOD = 12288, KAB = 3072;
constexpr float EPS = 1e-6f;
constexpr size_t MiB = 1u << 20;
constexpr size_t WS_CTL = 0, CTL_ZERO_BYTES = 1 * MiB;
constexpr size_t WS_MOD = 64 * 1024, WS_STATS = 128 * 1024;
constexpr size_t WS_CNT = 192 * 1024;
constexpr size_t WS_XBUF = 1 * MiB + 128 * 1024;
constexpr size_t WS_VEC = 1 * MiB;
constexpr size_t WS_WIN = 2 * MiB, WS_WAB = 38 * MiB, WS_WOUT = 50 * MiB, WS_WUP = 58 * MiB, WS_WDN = 102 * MiB, WS_WPOOL = 124 * MiB, WS_WSP = WS_WPOOL + 512 * 1024;
constexpr size_t WS_H1 = 125 * MiB, WS_U = 157 * MiB, WS_V = 189 * MiB, WS_P = 221 * MiB, WS_GA = 237 * MiB, WS_GB = 269 * MiB;
constexpr size_t WS_SGPB = 301 * MiB, WS_MERGED = 349 * MiB, WS_MIX = 125 * MiB, WS_H2 = 301 * MiB, WS_ACT = 125 * MiB, WS_Y = 213 * MiB;
constexpr size_t WS_RAWB = 389 * MiB;
constexpr size_t WS_END = 395 * MiB;
constexpr int CW_BAR = 4096;
static_assert((CW_BAR + XCD_BAR_WORDS) * 4 <= (int)WS_MOD && WS_MOD + NMOD * 4 <= WS_STATS && WS_STATS + SEQ * 8 <= WS_CNT && WS_CNT + 3 * 32 * 256 <= CTL_ZERO_BYTES && WS_XBUF + 3 * 256 * 1024 <= 2 * MiB, "CTL map");
constexpr int RING_OFF = 0, RING_BYTES = 131072, LDSCTL_OFF = RING_BYTES, MISC_OFF = LDSCTL_OFF + 320, XCH_OFF = RING_BYTES + 1024, LDS_BYTES = 147456;

typedef unsigned v2u __attribute__((ext_vector_type(2)));
__device__ __forceinline__ float wave_sum(float v) {
#pragma unroll
    for (int o = 1; o < 64; o <<= 1) v += __shfl_xor(v, o);
    return v;
}
__device__ __forceinline__ float sigm(float z) { return __builtin_amdgcn_rcpf(1.0f + __builtin_amdgcn_exp2f(z * -1.44269504089f)); }
__device__ __forceinline__ float gelu_t(float x) { const float z = x * (1.5957691216f + 0.0713548163f * x * x); return x * sigm(z); }
__device__ __forceinline__ float bflo(unsigned w) { return __builtin_bit_cast(float, w << 16); }
__device__ __forceinline__ float bfhi(unsigned w) { return __builtin_bit_cast(float, w & 0xffff0000u); }

__device__ __forceinline__ void p0_mod_gemv(const float* c, const float* w_ada, const float* b_ada, float* MOD, LAS unsigned char* lds, int vcu, int G, int tid, int lane, int wave) {
    constexpr int NCG = NMOD / 256, NKR = DM / 128;
    LAS float* red = (LAS float*)lds;
    for (int it = vcu; it < NCG * NKR; it += G) {
        const int cg = it % NCG, kr = it / NCG, k0 = kr * 128 + wave * 16, col = cg * 256 + lane * 4;
        float cv = c[k0 + (lane & 15)]; cv = cv * sigm(cv);
        f32x4 a = (f32x4){0.f, 0.f, 0.f, 0.f};
#pragma unroll
        for (int kk = 0; kk < 16; ++kk) { const float s = __shfl(cv, kk); const f32x4 w = __builtin_nontemporal_load((const f32x4*)(w_ada + (size_t)(k0 + kk) * NMOD + col)); a += w * s; }
        *(LAS f32x4*)(red + wave * 256 + lane * 4) = a;
        __syncthreads();
        if (tid < 256) { float s = 0.f;
#pragma unroll
            for (int w = 0; w < 8; ++w) s += red[w * 256 + tid];
            if (kr == 0) s += b_ada[cg * 256 + tid];
            atomicAdd(MOD + cg * 256 + tid, s); }
        __syncthreads();
    }
}
struct TrDesc { const float* W; bf16* WT; int N, dpitch, koff, item; };
__device__ __forceinline__ void tr_load(const TrDesc& d, int lane, float (&tmp)[32]) {
    const int nblk = d.N / 32, kb = d.item / nblk, nb = d.item % nblk, k0 = 64 * kb, n0 = 32 * nb;
    const float* src = d.W + (size_t)(k0 + (lane >> 5)) * d.N + n0 + (lane & 31);
#pragma unroll
    for (int i = 0; i < 32; ++i) tmp[i] = __builtin_nontemporal_load(src + (size_t)(2 * i) * d.N);
}
__device__ __forceinline__ void tr_store(const TrDesc& d, const float (&tmp)[32], LAS float* scr, int lane) {
    const int nblk = d.N / 32, kb = d.item / nblk, nb = d.item % nblk, k0 = 64 * kb, n0 = 32 * nb;
#pragma unroll
    for (int i = 0; i < 32; ++i) scr[(2 * i + (lane >> 5)) * 33 + (lane & 31)] = tmp[i];
    LDS_WAIT(); asm volatile("" ::: "memory");
    const int c = lane & 7;
#pragma unroll
    for (int j = 0; j < 4; ++j) { const int n = (lane >> 3) + 8 * j; const LAS float* s = scr + (8 * c) * 33 + n;
        v4u o; o.x = pg8::cvt_pk_bf16(s[0 * 33], s[1 * 33]); o.y = pg8::cvt_pk_bf16(s[2 * 33], s[3 * 33]); o.z = pg8::cvt_pk_bf16(s[4 * 33], s[5 * 33]); o.w = pg8::cvt_pk_bf16(s[6 * 33], s[7 * 33]);
        *(v4u*)(d.WT + (size_t)(n0 + n) * d.dpitch + d.koff + k0 + 8 * c) = o; }
    LDS_WAIT(); asm volatile("" ::: "memory");
}
template <class L> __device__ __forceinline__ void convert_list(const L& list, int n, int start, int stride, LAS float* scr, int lane) {
    float ta[32], tb[32]; TrDesc da, db; int it = start;
    if (it < n) { da = list.get(it); tr_load(da, lane, ta); }
    while (it < n) {
        int it2 = it + stride; if (it2 < n) { db = list.get(it2); tr_load(db, lane, tb); }
        tr_store(da, ta, scr, lane);
        it = it2; if (it >= n) break;
        it2 = it + stride; if (it2 < n) { da = list.get(it2); tr_load(da, lane, ta); }
        tr_store(db, tb, scr, lane);
        it = it2;
    }
}
struct ListOne { const float* W; bf16* WT; int N, dpitch, koff, first; __device__ __forceinline__ TrDesc get(int r) const { return TrDesc{W, WT, N, dpitch, koff, first + r}; } };
struct ListP0 {
    const float *win, *wpool; bf16 *Win_t, *WpT;
    static constexpr int I_IN = (DM / 64) * (INC / 32), I_P = (256 / 64) * (256 / 32), NITEMS = I_IN + 4 * I_P;
    __device__ __forceinline__ TrDesc get(int r) const {
        if (r < I_IN) return TrDesc{win, Win_t, INC, DM, 0, r}; r -= I_IN;
        const int gi = r / I_P; return TrDesc{wpool + (size_t)gi * 65536, WpT + (size_t)gi * 65536, 256, 256, 0, r % I_P};
    }
};
struct ListP2 {
    const float *wa, *wb, *wout, *wup; bf16 *Wab_t, *Wout_t, *Wup_t;
    static constexpr int I_A = (AW / 64) * (DM / 32), I_B = (BW / 64) * (DM / 32), I_O = (DM / 64) * (DM / 32), I_U = (DM / 64) * (FF2 / 32), NITEMS = I_A + I_B + I_O + I_U;
    __device__ __forceinline__ TrDesc get(int r) const {
        if (r < I_A) return TrDesc{wa, Wab_t, DM, KAB, 0, r}; r -= I_A;
        if (r < I_B) return TrDesc{wb, Wab_t, DM, KAB, AW, r}; r -= I_B;
        if (r < I_O) return TrDesc{wout, Wout_t, DM, DM, 0, r}; r -= I_O;
        return TrDesc{wup, Wup_t, FF2, DM, 0, r};
    }
};

typedef short v4s __attribute__((ext_vector_type(4)));
__device__ __forceinline__ void p3_spatial(LAS unsigned char* lds, int n, int h, const bf16* V, const bf16* U, const float* stats, const float* ln_g, const float* ln_b,
                                           const bf16* Wsp, const float* b_sp, bf16* SGPB, int tid, int lane, int wave) {
    LAS float* MR = (LAS float*)lds;
    LAS bf16* IM = (LAS bf16*)(lds + 2048);
    const int t0 = n * 128, d0 = h * 256;
    const int fr = lane & 15, fq = lane >> 4;
    float st_s = 0.f, st_q = 0.f;
    if (tid < 128) { st_s = stats[2 * (t0 + tid)]; st_q = stats[2 * (t0 + tid) + 1]; }
    const int c8 = (tid & 31) * 8, j0 = tid >> 5;
    v4u rawv[8];
#pragma unroll
    for (int it = 0; it < 8; ++it) rawv[it] = __builtin_nontemporal_load((const v4u*)(V + (size_t)(t0 + j0 + 16 * it) * AW + d0 + c8));
    const f32x4 g0 = *(const f32x4*)(ln_g + d0 + c8), g1 = *(const f32x4*)(ln_g + d0 + c8 + 4), b0 = *(const f32x4*)(ln_b + d0 + c8), b1 = *(const f32x4*)(ln_b + d0 + c8 + 4);
    const bf16* wbase = Wsp + (size_t)h * 16384;
    bf16x8 wf[4][8];
#pragma unroll
    for (int ks = 0; ks < 4; ++ks)
#pragma unroll
        for (int ib = 0; ib < 8; ++ib) if (32 * ks <= 16 * ib + 15) wf[ks][ib] = *(const bf16x8*)(wbase + (16 * ib + fr) * 128 + 32 * ks + 8 * fq);
    asm volatile("" ::: "memory");
    if (tid < 128) { const float mu = st_s * (1.0f / AW), var = fmaxf(st_q * (1.0f / AW) - mu * mu, 0.f), rstd = 1.0f / sqrtf(var + EPS);
        MR[2 * tid] = rstd; MR[2 * tid + 1] = -mu * rstd; }
    __syncthreads();
#pragma unroll
    for (int it = 0; it < 8; ++it) { const int j = j0 + 16 * it; const float rs = MR[2 * j], cc = MR[2 * j + 1]; const v4u raw = rawv[it];
        const f32x4 va = (f32x4){bflo(raw.x), bfhi(raw.x), bflo(raw.y), bfhi(raw.y)}, vb = (f32x4){bflo(raw.z), bfhi(raw.z), bflo(raw.w), bfhi(raw.w)};
        const f32x4 oa = (va * rs + cc) * g0 + b0, ob = (vb * rs + cc) * g1 + b1;
        v4u pk; pk.x = pg8::cvt_pk_bf16(oa[0], oa[1]); pk.y = pg8::cvt_pk_bf16(oa[2], oa[3]); pk.z = pg8::cvt_pk_bf16(ob[0], ob[1]); pk.w = pg8::cvt_pk_bf16(ob[2], ob[3]);
        *(LAS v4u*)(IM + j * 264 + c8) = pk; }
    __syncthreads();
    f32x4 acc[2][8];
#pragma unroll
    for (int a = 0; a < 2; ++a)
#pragma unroll
        for (int b = 0; b < 8; ++b) acc[a][b] = (f32x4){0.f, 0.f, 0.f, 0.f};
    const LAS bf16* trb = IM + (8 * fq + (fr >> 2)) * 264 + 32 * wave + 4 * (fr & 3);
#pragma unroll
    for (int ks = 0; ks < 4; ++ks) {
        bf16x8 a[2];
#pragma unroll
        for (int dbi = 0; dbi < 2; ++dbi) {
            const v4s lo = __builtin_amdgcn_ds_read_tr16_b64_v4i16((LAS v4s*)(trb + (32 * ks) * 264 + 16 * dbi));
            const v4s hi = __builtin_amdgcn_ds_read_tr16_b64_v4i16((LAS v4s*)(trb + (32 * ks + 4) * 264 + 16 * dbi));
            a[dbi] = (bf16x8){lo[0], lo[1], lo[2], lo[3], hi[0], hi[1], hi[2], hi[3]}; }
#pragma unroll
        for (int ib = 0; ib < 8; ++ib) {
            if (32 * ks <= 16 * ib + 15) {
                const bf16x8 b = wf[ks][ib];
#pragma unroll
                for (int dbi = 0; dbi < 2; ++dbi) acc[dbi][ib] = __builtin_amdgcn_mfma_f32_16x16x32_bf16(a[dbi], b, acc[dbi][ib], 0, 0, 0);
            }
        }
    }
    v4u uu[8];
#pragma unroll
    for (int it = 0; it < 8; ++it) { const int idx = tid + 512 * it; uu[it] = __builtin_nontemporal_load((const v4u*)(U + (size_t)(t0 + (idx >> 5)) * AW + d0 + (idx & 31) * 8)); }
    __syncthreads();
    LAS bf16* OUT = IM;
#pragma unroll
    for (int ib = 0; ib < 8; ++ib) { const int i = 16 * ib + fr; const float bs = b_sp[h * 128 + i];
#pragma unroll
        for (int dbi = 0; dbi < 2; ++dbi) { const f32x4 m = acc[dbi][ib] + bs;
            v2u o; o.x = pg8::cvt_pk_bf16(m[0], m[1]); o.y = pg8::cvt_pk_bf16(m[2], m[3]);
            *(LAS v2u*)(OUT + i * 264 + 16 * (2 * wave + dbi) + 4 * fq) = o; } }
    __syncthreads();
#pragma unroll
    for (int it = 0; it < 8; ++it) { const int idx = tid + 512 * it, i = idx >> 5, cc8 = (idx & 31) * 8;
        const v4u mx = *(const LAS v4u*)(OUT + i * 264 + cc8); const v4u ux = uu[it];
        v4u o; o.x = pg8::cvt_pk_bf16(bflo(ux.x) * bflo(mx.x), bfhi(ux.x) * bfhi(mx.x)); o.y = pg8::cvt_pk_bf16(bflo(ux.y) * bflo(mx.y), bfhi(ux.y) * bfhi(mx.y));
        o.z = pg8::cvt_pk_bf16(bflo(ux.z) * bflo(mx.z), bfhi(ux.z) * bfhi(mx.z)); o.w = pg8::cvt_pk_bf16(bflo(ux.w) * bflo(mx.w), bfhi(ux.w) * bfhi(mx.w));
        *(v4u*)(SGPB + (size_t)(t0 + i) * KAB + d0 + cc8) = o; }
}
__device__ __forceinline__ void p3_pool(LAS unsigned char* lds, int r, int gi, const bf16* P, const bf16* WpT, const float* pscale, bf16* SGPB, int tid, int lane, int wave) {
    LAS bf16* Ap = (LAS bf16*)lds;
    const int t0 = r * 128, win = 2 << gi;
    const int fr = lane & 15, fq = lane >> 4;
    const bf16* wbase = WpT + (size_t)gi * 65536;
    bf16x8 af[8][2];
#pragma unroll
    for (int ks = 0; ks < 8; ++ks)
#pragma unroll
        for (int ebi = 0; ebi < 2; ++ebi) af[ks][ebi] = *(const bf16x8*)(wbase + (16 * (2 * wave + ebi) + fr) * 256 + 32 * ks + 8 * fq);
    {
        const int q8 = (tid & 31) * 8, tl0 = (tid >> 5) * 8; const bf16* pc = P + gi * 256 + q8;
        float sum[8] = {0.f, 0.f, 0.f, 0.f, 0.f, 0.f, 0.f, 0.f};
#pragma unroll
        for (int sI = 1; sI < 16; ++sI) { const int ts = t0 + tl0 - sI; const float fct = (sI < win && ts >= 0) ? 1.f : 0.f;
            const v4u raw = *(const v4u*)(pc + (size_t)(ts >= 0 ? ts : 0) * BW);
            sum[0] += fct * bflo(raw.x); sum[1] += fct * bfhi(raw.x); sum[2] += fct * bflo(raw.y); sum[3] += fct * bfhi(raw.y); sum[4] += fct * bflo(raw.z); sum[5] += fct * bfhi(raw.z); sum[6] += fct * bflo(raw.w); sum[7] += fct * bfhi(raw.w); }
#pragma unroll
        for (int k = 0; k < 8; ++k) { const int t = t0 + tl0 + k; const v4u raw = *(const v4u*)(pc + (size_t)t * BW);
            const float self[8] = {bflo(raw.x), bfhi(raw.x), bflo(raw.y), bfhi(raw.y), bflo(raw.z), bfhi(raw.z), bflo(raw.w), bfhi(raw.w)};
#pragma unroll
            for (int e = 0; e < 8; ++e) sum[e] += self[e];
            const int cnt = (t + 1 < win) ? (t + 1) : win; const float inv = 1.0f / (float)cnt;
            v4u o; o.x = pg8::cvt_pk_bf16(sum[0] * inv - self[0], sum[1] * inv - self[1]); o.y = pg8::cvt_pk_bf16(sum[2] * inv - self[2], sum[3] * inv - self[3]);
            o.z = pg8::cvt_pk_bf16(sum[4] * inv - self[4], sum[5] * inv - self[5]); o.w = pg8::cvt_pk_bf16(sum[6] * inv - self[6], sum[7] * inv - self[7]);
            *(LAS v4u*)(Ap + (tl0 + k) * 264 + q8) = o;
            const int td = t - win + 1;
            { const float fct = (td >= 0) ? 1.f : 0.f; const v4u rd = *(const v4u*)(pc + (size_t)(td >= 0 ? td : 0) * BW);
                sum[0] -= fct * bflo(rd.x); sum[1] -= fct * bfhi(rd.x); sum[2] -= fct * bflo(rd.y); sum[3] -= fct * bfhi(rd.y); sum[4] -= fct * bflo(rd.z); sum[5] -= fct * bfhi(rd.z); sum[6] -= fct * bflo(rd.w); sum[7] -= fct * bfhi(rd.w); } }
    }
    __syncthreads();
    f32x4 acc[2][8];
#pragma unroll
    for (int a = 0; a < 2; ++a)
#pragma unroll
        for (int b = 0; b < 8; ++b) acc[a][b] = (f32x4){0.f, 0.f, 0.f, 0.f};
#pragma unroll
    for (int ks = 0; ks < 8; ++ks) {
        bf16x8 a[2];
#pragma unroll
        for (int ebi = 0; ebi < 2; ++ebi) a[ebi] = af[ks][ebi];
#pragma unroll
        for (int tb = 0; tb < 8; ++tb) { const bf16x8 b = *(const LAS bf16x8*)(Ap + (16 * tb + fr) * 264 + 32 * ks + 8 * fq);
#pragma unroll
            for (int ebi = 0; ebi < 2; ++ebi) acc[ebi][tb] = __builtin_amdgcn_mfma_f32_16x16x32_bf16(a[ebi], b, acc[ebi][tb], 0, 0, 0); }
    }
    __syncthreads();
#pragma unroll
    for (int ebi = 0; ebi < 2; ++ebi) { const int e = 16 * (2 * wave + ebi) + 4 * fq; const f32x4 sc = *(const f32x4*)(pscale + gi * 256 + e);
#pragma unroll
        for (int tb = 0; tb < 8; ++tb) { const f32x4 m = acc[ebi][tb] * sc;
            v2u o; o.x = pg8::cvt_pk_bf16(m[0], m[1]); o.y = pg8::cvt_pk_bf16(m[2], m[3]);
            *(LAS v2u*)(Ap + (16 * tb + fr) * 264 + e) = o; } }
    __syncthreads();
#pragma unroll
    for (int it = 0; it < 8; ++it) { const int idx = tid + 512 * it, t = idx >> 5, c8 = (idx & 31) * 8;
        *(v4u*)(SGPB + (size_t)(t0 + t) * KAB + AW + gi * 256 + c8) = *(const LAS v4u*)(Ap + t * 264 + c8); }
}

struct Params { const float* in[22]; float* out; unsigned char* ws; int ph_lo, ph_hi; };
enum { I_X = 0, I_C, I_WADA, I_BADA, I_GPREMIX, I_GPOSTMIX, I_WIN, I_LNG, I_LNB, I_WSP, I_BSP, I_WPOOL, I_PSCALE, I_WA, I_WB, I_WOUT, I_GPREFFN, I_GPOSTFFN, I_WUP, I_CONVW, I_CONVB, I_WDN };

__global__ void __launch_bounds__(NWAVES * 64, 2) fwd_megakernel(Params p) {
    extern __shared__ __attribute__((aligned(16))) unsigned char lds_raw[];
    LAS unsigned char* lds = (LAS unsigned char*)lds_raw;
    volatile LAS unsigned* MISC = (volatile LAS unsigned*)(lds + MISC_OFF);
    const int tid = threadIdx.x, lane = tid & 63, wave = __builtin_amdgcn_readfirstlane(tid >> 6);
    const int G = gridDim.x, bx = blockIdx.x, vcu = (G % 8 == 0) ? (bx % 8) * (G / 8) + bx / 8 : bx;
    const int gw = vcu * NWAVES + wave, NGW = G * NWAVES;
    unsigned char* ws = p.ws;
    for (int u = tid; u < (LDS_BYTES - LDSCTL_OFF) / 4; u += NWAVES * 64) ((LAS unsigned*)(lds + LDSCTL_OFF))[u] = 0u;
    __syncthreads();
    const int lo = p.ph_lo, hi = p.ph_hi;
    XcdBarrier bar; bar.bar = (unsigned*)(ws + WS_CTL) + CW_BAR; bar.x = 0; bar.st = nullptr;
    if (hi - lo > 1) bar = xcd_barrier_post((unsigned*)(ws + WS_CTL) + CW_BAR, MISC + 8);
#define IN(k) (lo <= (k) && (k) < hi)
#define SEAM(k) do { if (IN(k) && IN((k) + 1)) xcd_barrier(bar); } while (0)

    float* MOD = (float*)(ws + WS_MOD); float* STATS = (float*)(ws + WS_STATS); float* VEC = (float*)(ws + WS_VEC);
    bf16 *Win_t = (bf16*)(ws + WS_WIN), *Wab_t = (bf16*)(ws + WS_WAB), *Wout_t = (bf16*)(ws + WS_WOUT), *Wup_t = (bf16*)(ws + WS_WUP), *Wdn_t = (bf16*)(ws + WS_WDN), *WpT = (bf16*)(ws + WS_WPOOL), *Wsp = (bf16*)(ws + WS_WSP);
    bf16 *H1 = (bf16*)(ws + WS_H1), *Ub = (bf16*)(ws + WS_U), *Vb = (bf16*)(ws + WS_V), *Pb = (bf16*)(ws + WS_P), *GA = (bf16*)(ws + WS_GA), *GB = (bf16*)(ws + WS_GB);
    bf16 *SGPB = (bf16*)(ws + WS_SGPB), *MERGED = (bf16*)(ws + WS_MERGED), *ACT = (bf16*)(ws + WS_ACT), *H2 = (bf16*)(ws + WS_H2);
    float *MIX = (float*)(ws + WS_MIX), *Y = (float*)(ws + WS_Y), *RAWB = (float*)(ws + WS_RAWB);
    const float* x = p.in[I_X]; float* out = p.out;

    unsigned* const gcnt = (unsigned*)(ws + WS_CTL) + 16;
    const bool split = false;
    const bool gemv_role = !split || (((bx >> 3) & 1) == 0);
    const int n_gemv = split ? G / 2 : G, i_gemv = split ? (bx >> 4) * 8 + (bx & 7) : vcu, n_conv = split ? G / 2 : G, i_conv = split ? (bx >> 4) * 8 + (bx & 7) : vcu;
    if (IN(0)) {
        if (gemv_role) {
            p0_mod_gemv(p.in[I_C], p.in[I_WADA], p.in[I_BADA], MOD, lds + RING_OFF, i_gemv, n_gemv, tid, lane, wave);
            VM_WAIT(); __syncthreads();
            if (tid == 0) __hip_atomic_fetch_add(gcnt, 1u, RLX_AGENT);
        }
        if (!split || !gemv_role) { LAS float* scr = (LAS float*)(lds + RING_OFF + wave * 16384);
            const ListP0 L{p.in[I_WIN], p.in[I_WPOOL], Win_t, WpT}; convert_list(L, ListP0::NITEMS, i_conv * NWAVES + wave, n_conv * NWAVES, scr, lane); }
        for (int idx = gw * 64 + lane; idx < 8 * 128 * 128; idx += NGW * 64) { const int i = (idx >> 7) & 127, j = idx & 127; Wsp[idx] = (bf16)((j <= i) ? f2bf(p.in[I_WSP][idx]) : 0u); }
    }
    if (IN(0) && IN(1)) {
        if (wave == 0) { unsigned sp = 0;
            while ((unsigned)__builtin_amdgcn_readfirstlane(__hip_atomic_load(gcnt, RLX_AGENT)) < (unsigned)n_gemv) { __builtin_amdgcn_s_sleep(2); if (++sp > (1u << 20)) break; }
            __builtin_amdgcn_fence(__ATOMIC_ACQUIRE, "agent"); VM_WAIT(); }
        __syncthreads();
    }
    if (IN(1)) {
        if (bx == 0) for (int cc = tid; cc < DM; cc += NWAVES * 64) {
            VEC[cc] = MOD[2 * DM + cc] * p.in[I_GPOSTMIX][cc];
            VEC[DM + cc] = p.in[I_GPREFFN][cc] * (1.0f + MOD[4 * DM + cc]);
            VEC[2 * DM + cc] = MOD[3 * DM + cc];
            VEC[3 * DM + cc] = MOD[5 * DM + cc] * p.in[I_GPOSTFFN][cc]; }
        f32x4 ca[8], cb[8];
#pragma unroll
        for (int j = 0; j < 8; ++j) { const int cc = 8 * lane + 512 * (j >> 1) + 4 * (j & 1); const f32x4 g = *(const f32x4*)(p.in[I_GPREMIX] + cc), sc = *(const f32x4*)(MOD + DM + cc); ca[j] = g * (sc + 1.0f); cb[j] = *(const f32x4*)(MOD + cc); }
        {   int m = gw; f32x4 v[8], nx[8];
            if (m < SEQ) { const f32x4* xr = (const f32x4*)(x + (size_t)m * DM) + 2 * lane;
#pragma unroll
                for (int j = 0; j < 8; ++j) v[j] = __builtin_nontemporal_load(xr + 128 * (j >> 1) + (j & 1)); }
            for (; m < SEQ; m += NGW) {
                const int mn = (m + NGW < SEQ) ? m + NGW : m;
                { const f32x4* xr = (const f32x4*)(x + (size_t)mn * DM) + 2 * lane;
#pragma unroll
                  for (int j = 0; j < 8; ++j) nx[j] = __builtin_nontemporal_load(xr + 128 * (j >> 1) + (j & 1)); }
                asm volatile("" ::: "memory");
                float ss = 0.f;
#pragma unroll
                for (int j = 0; j < 8; ++j) ss += (v[j][0] * v[j][0] + v[j][1] * v[j][1]) + (v[j][2] * v[j][2] + v[j][3] * v[j][3]);
                const float rstd = 1.0f / sqrtf(wave_sum(ss) * (1.0f / DM) + EPS);
                v4u* o16 = (v4u*)(H1 + (size_t)m * DM) + lane;
#pragma unroll
                for (int jq = 0; jq < 4; ++jq) { const f32x4 ha = v[2 * jq] * rstd * ca[2 * jq] + cb[2 * jq], hb = v[2 * jq + 1] * rstd * ca[2 * jq + 1] + cb[2 * jq + 1];
                    v4u o; o.x = pg8::cvt_pk_bf16(ha[0], ha[1]); o.y = pg8::cvt_pk_bf16(ha[2], ha[3]); o.z = pg8::cvt_pk_bf16(hb[0], hb[1]); o.w = pg8::cvt_pk_bf16(hb[2], hb[3]); o16[64 * jq] = o; }
#pragma unroll
                for (int j = 0; j < 8; ++j) v[j] = nx[j];
            }
        }
    }
    SEAM(1);
    if (IN(2)) {
        pg8::Gemm g{H1, Win_t, SEQ, INC, DM}; pg8::StaticOrder S; S.init(SEQ, INC, G, bx);
        pg8::EpiIn E{Ub, Vb, Pb, GA, GB, STATS};
        pg8::gemm_phase<pg8::EpiIn, pg8::StaticOrder, true, true, 16>(lds + RING_OFF, g, S, E);
        {
            const int rem = (32 * 36) % G, nidle = rem ? G - rem : G, idle = rem ? bx - rem : bx;
            if (idle >= 0) { LAS float* scr = (LAS float*)(lds + RING_OFF + wave * 16384);
                const ListP2 L{p.in[I_WA], p.in[I_WB], p.in[I_WOUT], p.in[I_WUP], Wab_t, Wout_t, Wup_t}; convert_list(L, ListP2::NITEMS, idle * NWAVES + wave, nidle * NWAVES, scr, lane); }
        }
    }
    SEAM(2);
    if (IN(3)) {
        for (int u = vcu; u < 768; u += G) {
            __syncthreads();
            if (u < 512) p3_spatial(lds + RING_OFF, u >> 3, u & 7, Vb, Ub, STATS, p.in[I_LNG], p.in[I_LNB], Wsp, p.in[I_BSP], SGPB, tid, lane, wave);
            else p3_pool(lds + RING_OFF, (u - 512) >> 2, (u - 512) & 3, Pb, WpT, p.in[I_PSCALE], SGPB, tid, lane, wave);
        }
        __syncthreads();
    }
    SEAM(3);
    if (IN(4)) {
        pg8::Gemm g{SGPB, Wab_t, SEQ, DM, KAB}; pg8::StaticOrder S; S.init(SEQ, DM, G, bx);
        pg8::EpiMerge E{GA, GB, MERGED};
        pg8::gemm_phase<pg8::EpiMerge, pg8::StaticOrder, true, true>(lds + RING_OFF, g, S, E);
    }
    SEAM(4);
    const bool fuse = (G == 256);
    unsigned* const xb = (unsigned*)(ws + WS_XBUF); unsigned* const pc = (unsigned*)(ws + WS_CNT); unsigned* const tmo = (unsigned*)(ws + WS_CTL) + 2;
    if (IN(5)) {
        pg8::Gemm g{MERGED, Wout_t, SEQ, DM, DM}; pg8::StaticOrder S; S.init(SEQ, DM, G, bx);
        if (fuse) {
            pg8::EpiMixFused E{x, (bf16*)(ws + WS_Y), H2, VEC, pg8::PanelSS{xb, pc, tmo, EPS}, pg8::PanelSS{xb + 65536, pc + 2048, tmo, EPS}};
            pg8::gemm_phase<pg8::EpiMixFused, pg8::StaticOrder, false, true>(lds + RING_OFF, g, S, E);
        } else {
            pg8::EpiF32 E{MIX, DM};
            pg8::gemm_phase<pg8::EpiF32, pg8::StaticOrder, true, true>(lds + RING_OFF, g, S, E);
        }
    }
    if (!fuse) SEAM(5);
    if (IN(6) && !fuse) {
        {   int m = gw; f32x4 v[8], w[8], nv[8], nw[8];
            if (m < SEQ) { const f32x4* xr = (const f32x4*)(x + (size_t)m * DM) + lane; const f32x4* mr = (const f32x4*)(MIX + (size_t)m * DM) + lane;
#pragma unroll
                for (int j = 0; j < 8; ++j) { v[j] = xr[64 * j]; w[j] = mr[64 * j]; } }
            for (; m < SEQ; m += NGW) {
                const int mn = (m + NGW < SEQ) ? m + NGW : m;
                { const f32x4* xr = (const f32x4*)(x + (size_t)mn * DM) + lane; const f32x4* mr = (const f32x4*)(MIX + (size_t)mn * DM) + lane;
#pragma unroll
                  for (int j = 0; j < 8; ++j) { nv[j] = xr[64 * j]; nw[j] = mr[64 * j]; } }
                asm volatile("" ::: "memory");
                float ss = 0.f;
#pragma unroll
                for (int j = 0; j < 8; ++j) ss += (w[j][0] * w[j][0] + w[j][1] * w[j][1]) + (w[j][2] * w[j][2] + w[j][3] * w[j][3]);
                const float rstd = 1.0f / sqrtf(wave_sum(ss) * (1.0f / DM) + EPS); float s1 = 0.f;
                f32x4* o4 = (f32x4*)(out + (size_t)m * DM) + lane;
#pragma unroll
                for (int j = 0; j < 8; ++j) { const f32x4 g1 = *((const f32x4*)VEC + lane + 64 * j); v[j] = v[j] + g1 * (w[j] * rstd); o4[64 * j] = v[j];
                    s1 += (v[j][0] * v[j][0] + v[j][1] * v[j][1]) + (v[j][2] * v[j][2] + v[j][3] * v[j][3]); }
                const float rstd1 = 1.0f / sqrtf(wave_sum(s1) * (1.0f / DM) + EPS);
                uint2* o8 = (uint2*)(H2 + (size_t)m * DM) + lane;
#pragma unroll
                for (int j = 0; j < 8; ++j) { const f32x4 a2 = *((const f32x4*)(VEC + DM) + lane + 64 * j), b2 = *((const f32x4*)(VEC + 2 * DM) + lane + 64 * j);
                    const f32x4 h = v[j] * rstd1 * a2 + b2; uint2 o; o.x = pk2(h[0], h[1]); o.y = pk2(h[2], h[3]); o8[64 * j] = o; }
#pragma unroll
                for (int j = 0; j < 8; ++j) { v[j] = nv[j]; w[j] = nw[j]; }
            }
        }
    }
    SEAM(6);
    if (IN(7)) {
        pg8::Gemm g{H2, Wup_t, SEQ, FF2, DM, (size_t)FF * DM * 2, (size_t)128 * DM * 2}; pg8::StaticOrder S; S.init(SEQ, FF2, G, bx);
        pg8::EpiUpConv E{ACT, RAWB, p.in[I_CONVW], p.in[I_CONVB], lds + XCH_OFF};
        pg8::gemm_phase<pg8::EpiUpConv, pg8::StaticOrder, true, true, 0>(lds + RING_OFF, g, S, E);
        {
            const int rem = (32 * 44) % G, nidle = rem ? G - rem : G, idle = rem ? bx - rem : bx;
            if (idle >= 0) { LAS float* scr = (LAS float*)(lds + RING_OFF + wave * 16384);
                const ListOne L{p.in[I_WDN], Wdn_t, DM, FF, 0, 0}; convert_list(L, (FF / 64) * (DM / 32), idle * NWAVES + wave, nidle * NWAVES, scr, lane); }
        }
    }
    SEAM(7);
    if (IN(8)) {
        pg8::Gemm g{ACT, Wdn_t, SEQ, DM, FF}; pg8::FixOrder S; S.init(SEQ, DM, G, bx); S.ACT = ACT; S.RAWB = RAWB; S.cw = p.in[I_CONVW]; S.cb = p.in[I_CONVB];
        if (fuse) {
            pg8::EpiOutFused E{(const bf16*)(ws + WS_Y), out, VEC, pg8::PanelSS{xb + 2 * 65536, pc + 2 * 2048, tmo, EPS}};
            pg8::gemm_phase<pg8::EpiOutFused, pg8::FixOrder, false, true>(lds + RING_OFF, g, S, E);
        } else {
            pg8::EpiF32 E{Y, DM};
            pg8::gemm_phase<pg8::EpiF32, pg8::FixOrder, true, true>(lds + RING_OFF, g, S, E);
        }
    }
    if (!fuse) SEAM(8);
    if (IN(9) && !fuse) {
        {   int m = gw; f32x4 v[8], w[8], nv[8], nw[8];
            if (m < SEQ) { const f32x4* xr = (const f32x4*)(out + (size_t)m * DM) + lane; const f32x4* yr = (const f32x4*)(Y + (size_t)m * DM) + lane;
#pragma unroll
                for (int j = 0; j < 8; ++j) { v[j] = xr[64 * j]; w[j] = yr[64 * j]; } }
            for (; m < SEQ; m += NGW) {
                const bool has = (m + NGW < SEQ); const int mn = has ? m + NGW : m;
                if (has) { const f32x4* xr = (const f32x4*)(out + (size_t)mn * DM) + lane; const f32x4* yr = (const f32x4*)(Y + (size_t)mn * DM) + lane;
#pragma unroll
                  for (int j = 0; j < 8; ++j) { nv[j] = xr[64 * j]; nw[j] = yr[64 * j]; } }
                asm volatile("" ::: "memory");
                float ss = 0.f;
#pragma unroll
                for (int j = 0; j < 8; ++j) ss += (w[j][0] * w[j][0] + w[j][1] * w[j][1]) + (w[j][2] * w[j][2] + w[j][3] * w[j][3]);
                const float rstd = 1.0f / sqrtf(wave_sum(ss) * (1.0f / DM) + EPS);
                f32x4* o4 = (f32x4*)(out + (size_t)m * DM) + lane;
#pragma unroll
                for (int j = 0; j < 8; ++j) { const f32x4 g2 = *((const f32x4*)(VEC + 3 * DM) + lane + 64 * j); o4[64 * j] = v[j] + g2 * (w[j] * rstd); }
                if (has) {
#pragma unroll
                    for (int j = 0; j < 8; ++j) { v[j] = nv[j]; w[j] = nw[j]; } }
            }
        }
    }
#undef IN
#undef SEAM
}

extern "C" void kernel_launch(void* const* d_in, const int* in_sizes, int n_in, void* d_out, int out_size, void* d_ws, size_t ws_size, hipStream_t stream) {
    static int grid = 0;
    if (grid == 0) {
        if (n_in != 22 || in_sizes[0] != SEQ * DM || out_size != SEQ * DM || ws_size < WS_END) { fprintf(stderr, "kernel_launch: unexpected shapes (n_in %d, in0 %d, out %d, ws %zu < %zu)\n", n_in, n_in > 0 ? in_sizes[0] : -1, out_size, ws_size, (size_t)WS_END); grid = -1; return; }
        int dev = 0, cus = 0, per_cu = 0;
        if (hipGetDevice(&dev) != hipSuccess || hipDeviceGetAttribute(&cus, hipDeviceAttributeMultiprocessorCount, dev) != hipSuccess) { grid = -1; return; }
        if (hipFuncSetAttribute((const void*)fwd_megakernel, hipFuncAttributeMaxDynamicSharedMemorySize, LDS_BYTES) != hipSuccess) { fprintf(stderr, "kernel_launch: hipFuncSetAttribute failed\n"); grid = -1; return; }
        if (hipOccupancyMaxActiveBlocksPerMultiprocessor(&per_cu, (const void*)fwd_megakernel, NWAVES * 64, LDS_BYTES) != hipSuccess || per_cu < 1) { fprintf(stderr, "kernel_launch: occupancy query says %d blocks per CU\n", per_cu); grid = -1; (void)hipGetLastError(); return; }
        grid = cus;
    }
    if (grid < 0) return;
    (void)hipMemsetAsync((char*)d_ws + WS_CTL, 0, CTL_ZERO_BYTES, stream);
    Params a{};
    for (int i = 0; i < 22; ++i) a.in[i] = (const float*)d_in[i];
    a.out = (float*)d_out; a.ws = (unsigned char*)d_ws;
#if defined(PROBE_DUP)
    a.ph_lo = 0; a.ph_hi = PROBE_DUP + 1;
    hipLaunchKernelGGL(fwd_megakernel, dim3(grid), dim3(NWAVES * 64), LDS_BYTES, stream, a);
    (void)hipMemsetAsync((char*)d_ws + WS_CTL, 0, WS_MOD, stream);
    if (PROBE_DUP == 0) (void)hipMemsetAsync((char*)d_ws + WS_MOD, 0, NMOD * 4, stream);
    if (PROBE_DUP <= 2) (void)hipMemsetAsync((char*)d_ws + WS_STATS, 0, SEQ * 8, stream);
    a.ph_lo = PROBE_DUP; a.ph_hi = NPHASES;
    hipLaunchKernelGGL(fwd_megakernel, dim3(grid), dim3(NWAVES * 64), LDS_BYTES, stream, a);
#else
    for (int li = 0; li < N_LAUNCHES; ++li) {
        a.ph_lo = (N_LAUNCHES == 1) ? 0 : li; a.ph_hi = (N_LAUNCHES == 1) ? NPHASES : li + 1;
        hipLaunchKernelGGL(fwd_megakernel, dim3(grid), dim3(NWAVES * 64), LDS_BYTES, stream, a);
    }
#endif
}
```

```cpp
#include <hip/hip_runtime.h>
#include <cstdio>
#include <cstdint>
namespace pg8 {
#define PG8_LAS __attribute__((address_space(3)))
typedef unsigned short bf16_t;
typedef short bf16x8 __attribute__((ext_vector_type(8)));
typedef float f32x4 __attribute__((ext_vector_type(4)));
typedef unsigned u32x4 __attribute__((ext_vector_type(4)));
constexpr int BM = 256, BK = 64, HALF = 128, HTB = HALF * BK * 2  , STAGE_BYTES = 8 * HTB, NXCD = 8, WGM = 8;

__host__ __device__ __forceinline__ int lds_byte(int r, int c) { const int st = (r >> 4) * 2 + (c >> 5), rr = r & 15, cc = c & 31, ob = rr * 64 + cc * 2; return st * 1024 + (ob ^ (((ob >> 9) & 1) << 5)); }
__host__ __device__ __forceinline__ void stage_rc(int b, int& R, int& C) { const int st = b / 1024, sb = b % 1024, swz = sb ^ (((sb >> 9) & 1) << 5); R = (st >> 1) * 16 + swz / 64; C = (st & 1) * 32 + (swz % 64) / 2; }
__host__ __device__ __forceinline__ int perm32(int rho) { const int n = rho >> 4, i = rho & 15; return 8 * (i >> 2) + 4 * n + (i & 3); }

struct Unit { int pm, pn; };
struct Gemm { const bf16_t* A; const bf16_t* Bt; int M, N, K; size_t b_hstep, b_tstep; };

struct StaticOrder {
    int nM, nN, nwg, G, c;
    __host__ __device__ void init(int M, int N, int G_, int c_) { nM = M / BM; nN = N / BM; nwg = nM * nN; G = G_; c = c_; }
    __host__ __device__ bool next(int i, Unit& u) const {
        const long L = (long)i * G + c; if (L >= nwg) return false;
        int wgid = (int)L; { const int q = nwg / NXCD, r = nwg % NXCD, xcd = wgid % NXCD, off = wgid / NXCD; wgid = (xcd < r ? xcd * (q + 1) : r * (q + 1) + (xcd - r) * q) + off; }
        const int nig = WGM * nN, gid = wgid / nig, fm = gid * WGM, gsz = (nM - fm) < WGM ? (nM - fm) : WGM;
        u.pm = fm + ((wgid % nig) % gsz); u.pn = (wgid % nig) / gsz; return true;
    }
    __device__ __forceinline__ void a_ready(const Unit&) const {}
    __device__ __forceinline__ void done(const Unit&) const {}
};

__device__ __forceinline__ unsigned cvt_pk_bf16(float lo, float hi) { unsigned r; asm volatile("v_cvt_pk_bf16_f32 %0, %1, %2" : "=v"(r) : "v"(lo), "v"(hi)); return r; }
__device__ __forceinline__ float bf_lo(unsigned w) { return __builtin_bit_cast(float, w << 16); }
__device__ __forceinline__ float bf_hi(unsigned w) { return __builtin_bit_cast(float, w & 0xffff0000u); }
__device__ __forceinline__ float sigmoid_f(float z) { return __builtin_amdgcn_rcpf(1.0f + __builtin_amdgcn_exp2f(z * -1.44269504089f)); }
__device__ __forceinline__ float gelu_tanh_f(float x) { const float z = x * (1.5957691216f + 0.0713548163f * x * x); return x * sigmoid_f(z); }

typedef float f32x2 __attribute__((ext_vector_type(2)));
__device__ __forceinline__ f32x2 gelu_pk(f32x2 x) { const f32x2 t = (x * x) * (-0.102943264f) + (-2.302208198f); const f32x2 z = x * t;
    f32x2 e; e.x = __builtin_amdgcn_exp2f(z.x); e.y = __builtin_amdgcn_exp2f(z.y); e = e + 1.0f; f32x2 r; r.x = __builtin_amdgcn_rcpf(e.x); r.y = __builtin_amdgcn_rcpf(e.y); return x * r; }
__device__ __forceinline__ f32x2 sigmoid_pk(f32x2 x) { const f32x2 z = x * (-1.44269504089f);
    f32x2 e; e.x = __builtin_amdgcn_exp2f(z.x); e.y = __builtin_amdgcn_exp2f(z.y); e = e + 1.0f; f32x2 r; r.x = __builtin_amdgcn_rcpf(e.x); r.y = __builtin_amdgcn_rcpf(e.y); return r; }
__device__ __forceinline__ f32x4 gelu_v4(f32x4 v) { const f32x2 a = gelu_pk((f32x2){v[0], v[1]}), b = gelu_pk((f32x2){v[2], v[3]}); return (f32x4){a.x, a.y, b.x, b.y}; }
__device__ __forceinline__ f32x4 sigmoid_v4(f32x4 v) { const f32x2 a = sigmoid_pk((f32x2){v[0], v[1]}), b = sigmoid_pk((f32x2){v[2], v[3]}); return (f32x4){a.x, a.y, b.x, b.y}; }

struct EpiIn {
    static constexpr bool PERM = true, AFTER_DRAIN = false; static constexpr int MIDK = 0;
    bf16_t *U, *V, *P, *GA, *GB; float* stats;
    __device__ __forceinline__ void mid(f32x4 (&)[2][2][4][2], const Unit&, int, int, int, int) const {}
    __device__ __forceinline__ void operator()(const f32x4 (&acc)[2][2][4][2], const Unit& u, int wr, int wc, int fr, int fq) const {
        const int pn = u.pn; bf16_t* base; int ldc, colt, act;
        if (pn < 8) { base = U; ldc = 2048; colt = pn * BM; act = 1; }
        else if (pn < 16) { base = V; ldc = 2048; colt = (pn - 8) * BM; act = 3; }
        else if (pn < 20) { base = P; ldc = 1024; colt = (pn - 16) * BM; act = 0; }
        else if (pn < 28) { base = GA; ldc = 2048; colt = (pn - 20) * BM; act = 2; }
        else { base = GB; ldc = 2048; colt = (pn - 28) * BM; act = 2; }
        const int row0 = u.pm * BM + wr * 64 + fr, col0 = colt + wc * 32 + 8 * fq;
#pragma unroll
        for (int ai = 0; ai < 2; ++ai)
#pragma unroll
            for (int m = 0; m < 4; ++m) { const int row = row0 + ai * HALF + m * 16; bf16_t* rowp = base + (size_t)row * ldc + col0; float s = 0.f, q = 0.f;
#pragma unroll
                for (int bj = 0; bj < 2; ++bj) { f32x4 v0 = acc[ai][bj][m][0], v1 = acc[ai][bj][m][1];
                    if (act == 1 || act == 3) { v0 = gelu_v4(v0); v1 = gelu_v4(v1); }
                    else if (act == 2) { v0 = sigmoid_v4(v0); v1 = sigmoid_v4(v1); }
                    if (act == 3) {
#pragma unroll
                        for (int j = 0; j < 4; ++j) { s += v0[j] + v1[j]; q += v0[j] * v0[j] + v1[j] * v1[j]; } }
                    u32x4 w; w.x = cvt_pk_bf16(v0[0], v0[1]); w.y = cvt_pk_bf16(v0[2], v0[3]); w.z = cvt_pk_bf16(v1[0], v1[1]); w.w = cvt_pk_bf16(v1[2], v1[3]);
                    *(u32x4*)(rowp + bj * HALF) = w; }
                if (act == 3) { s += __shfl_xor(s, 16); s += __shfl_xor(s, 32); q += __shfl_xor(q, 16); q += __shfl_xor(q, 32);
                    if (fq == 0) { atomicAdd(stats + 2 * row, s); atomicAdd(stats + 2 * row + 1, q); } } }
    }
};
struct EpiBf16Plain {
    static constexpr bool PERM = true, AFTER_DRAIN = false; static constexpr int MIDK = 0;
    bf16_t* O; int ldc;
    __device__ __forceinline__ void mid(f32x4 (&)[2][2][4][2], const Unit&, int, int, int, int) const {}
    __device__ __forceinline__ void operator()(const f32x4 (&acc)[2][2][4][2], const Unit& u, int wr, int wc, int fr, int fq) const {
        const int row0 = u.pm * BM + wr * 64 + fr, col0 = u.pn * BM + wc * 32 + 8 * fq;
#pragma unroll
        for (int ai = 0; ai < 2; ++ai)
#pragma unroll
            for (int m = 0; m < 4; ++m) { bf16_t* rowp = O + (size_t)(row0 + ai * HALF + m * 16) * ldc + col0;
#pragma unroll
                for (int bj = 0; bj < 2; ++bj) { const f32x4 v0 = acc[ai][bj][m][0], v1 = acc[ai][bj][m][1];
                    u32x4 w; w.x = cvt_pk_bf16(v0[0], v0[1]); w.y = cvt_pk_bf16(v0[2], v0[3]); w.z = cvt_pk_bf16(v1[0], v1[1]); w.w = cvt_pk_bf16(v1[2], v1[3]);
                    *(u32x4*)(rowp + bj * HALF) = w; } }
    }
};
struct EpiMerge {
    static constexpr bool PERM = true, AFTER_DRAIN = false; static constexpr int MIDK = 32;
    const bf16_t *GA, *GB; bf16_t* O;
    __device__ __forceinline__ void mid(f32x4 (&acc)[2][2][4][2], const Unit& u, int wr, int wc, int fr, int fq) const {
        int row0 = u.pm * BM + wr * 64 + fr; const int col0 = u.pn * BM + wc * 32 + 8 * fq;
        asm volatile("" : "+v"(row0));
#pragma unroll
        for (int ai = 0; ai < 2; ++ai)
#pragma unroll
            for (int m = 0; m < 4; ++m) { const size_t off = (size_t)(row0 + ai * HALF + m * 16) * 2048 + col0;
#pragma unroll
                for (int bj = 0; bj < 2; ++bj) { const u32x4 a = *(const u32x4*)(GA + off + bj * HALF), b = *(const u32x4*)(GB + off + bj * HALF);
                    f32x4 r0, r1;
                    r0[0] = bf_lo(a.x) * __builtin_amdgcn_rcpf(bf_lo(b.x)); r0[1] = bf_hi(a.x) * __builtin_amdgcn_rcpf(bf_hi(b.x));
                    r0[2] = bf_lo(a.y) * __builtin_amdgcn_rcpf(bf_lo(b.y)); r0[3] = bf_hi(a.y) * __builtin_amdgcn_rcpf(bf_hi(b.y));
                    r1[0] = bf_lo(a.z) * __builtin_amdgcn_rcpf(bf_lo(b.z)); r1[1] = bf_hi(a.z) * __builtin_amdgcn_rcpf(bf_hi(b.z));
                    r1[2] = bf_lo(a.w) * __builtin_amdgcn_rcpf(bf_lo(b.w)); r1[3] = bf_hi(a.w) * __builtin_amdgcn_rcpf(bf_hi(b.w));
                    acc[ai][bj][m][0] *= r0; acc[ai][bj][m][1] *= r1; }
                asm volatile("" ::: "memory"); }
    }
    __device__ __forceinline__ void operator()(const f32x4 (&acc)[2][2][4][2], const Unit& u, int wr, int wc, int fr, int fq) const {
        int row0 = u.pm * BM + wr * 64 + fr; const int col0 = u.pn * BM + wc * 32 + 8 * fq;
        asm volatile("" : "+v"(row0));
#pragma unroll
        for (int ai = 0; ai < 2; ++ai)
#pragma unroll
            for (int m = 0; m < 4; ++m) { const size_t off = (size_t)(row0 + ai * HALF + m * 16) * 2048 + col0;
#pragma unroll
                for (int bj = 0; bj < 2; ++bj) { const u32x4 b = *(const u32x4*)(GB + off + bj * HALF); const f32x4 v0 = acc[ai][bj][m][0], v1 = acc[ai][bj][m][1];
                    u32x4 w; w.x = cvt_pk_bf16(v0[0] * bf_lo(b.x), v0[1] * bf_hi(b.x)); w.y = cvt_pk_bf16(v0[2] * bf_lo(b.y), v0[3] * bf_hi(b.y));
                    w.z = cvt_pk_bf16(v1[0] * bf_lo(b.z), v1[1] * bf_hi(b.z)); w.w = cvt_pk_bf16(v1[2] * bf_lo(b.w), v1[3] * bf_hi(b.w));
                    *(u32x4*)(O + off + bj * HALF) = w; }
                asm volatile("" ::: "memory"); }
    }
};
struct EpiF32 {
    static constexpr bool PERM = false, AFTER_DRAIN = false; static constexpr int MIDK = 0;
    float* C; int ldc;
    __device__ __forceinline__ void mid(f32x4 (&)[2][2][4][2], const Unit&, int, int, int, int) const {}
    __device__ __forceinline__ void operator()(const f32x4 (&acc)[2][2][4][2], const Unit& u, int wr, int wc, int fr, int fq) const {
        const int row0 = u.pm * BM + wr * 64 + fr, col0 = u.pn * BM + wc * 32 + 4 * fq;
#pragma unroll
        for (int ai = 0; ai < 2; ++ai)
#pragma unroll
            for (int m = 0; m < 4; ++m) { float* rowp = C + (size_t)(row0 + ai * HALF + m * 16) * ldc + col0;
#pragma unroll
                for (int bj = 0; bj < 2; ++bj)
#pragma unroll
                    for (int n = 0; n < 2; ++n) *(f32x4*)(rowp + bj * HALF + n * 16) = acc[ai][bj][m][n]; }
    }
};

constexpr int UPF = 5632, UPF2 = 11264;
template <int CTRL> __device__ __forceinline__ float dpp_mov(float old, float src) {
    return __builtin_bit_cast(float, __builtin_amdgcn_update_dpp(__builtin_bit_cast(int, old), __builtin_bit_cast(int, src), CTRL, 0xF, 0xF, false)); }
template <int CTRL> __device__ __forceinline__ float dpp_rot(float src) {
    return __builtin_bit_cast(float, __builtin_amdgcn_mov_dpp(__builtin_bit_cast(int, src), CTRL, 0xF, 0xF, false)); }
struct EpiUpConv {
    static constexpr bool PERM = true, AFTER_DRAIN = false; static constexpr int MIDK = 0;
    bf16_t* ACT; float* RAWB; const float* cw; const float* cb; PG8_LAS unsigned char* xch;
    __device__ __forceinline__ void mid(f32x4 (&)[2][2][4][2], const Unit&, int, int, int, int) const {}
    __device__ __forceinline__ void operator()(const f32x4 (&acc)[2][2][4][2], const Unit& u, int wr, int wc, int fr, int fq) const {
        const int colh = 32 * wc + 8 * fq; int ca = u.pn * HALF + colh;
        asm volatile("" : "+v"(ca));
        PG8_LAS float* X = (PG8_LAS float*)xch;
#pragma unroll
        for (int ai = 0; ai < 2; ++ai) { const int s = 2 * ai + wr;
            if (fr >= 14) {
                if (s < 3) {
#pragma unroll
                    for (int bj = 0; bj < 2; ++bj)
#pragma unroll
                        for (int n = 0; n < 2; ++n) *(PG8_LAS f32x4*)(X + ((s * 2 + (fr - 14)) * 256 + bj * HALF + colh + 4 * n)) = acc[ai][bj][3][n];
                } else {
#pragma unroll
                    for (int bj = 0; bj < 2; ++bj)
#pragma unroll
                        for (int n = 0; n < 2; ++n) *(f32x4*)(RAWB + ((size_t)(u.pm * 4 + 2 + (fr - 14)) * UPF2 + bj * UPF + ca + 4 * n)) = acc[ai][bj][3][n];
                } } }
        if (wr == 0 && fr < 2) {
#pragma unroll
            for (int bj = 0; bj < 2; ++bj)
#pragma unroll
                for (int n = 0; n < 2; ++n) *(f32x4*)(RAWB + ((size_t)(u.pm * 4 + fr) * UPF2 + bj * UPF + ca + 4 * n)) = acc[0][bj][0][n]; }
        asm volatile("s_waitcnt lgkmcnt(0)" ::: "memory"); __builtin_amdgcn_s_barrier(); asm volatile("" ::: "memory");
        f32x4 w0[2][2], w1[2][2], w2[2][2], bb[2][2];
#pragma unroll
        for (int bj = 0; bj < 2; ++bj)
#pragma unroll
            for (int n = 0; n < 2; ++n) { const float* pc = cw + bj * UPF + ca + 4 * n; w0[bj][n] = *(const f32x4*)pc; w1[bj][n] = *(const f32x4*)(pc + UPF2); w2[bj][n] = *(const f32x4*)(pc + 2 * UPF2);
                bb[bj][n] = *(const f32x4*)(cb + bj * UPF + ca + 4 * n); }
#pragma unroll
        for (int ai = 0; ai < 2; ++ai) {
            f32x4 pv[2][2]; const int sp = 2 * ai + wr - 1;
#pragma unroll
            for (int bj = 0; bj < 2; ++bj)
#pragma unroll
                for (int n = 0; n < 2; ++n) pv[bj][n] = (sp >= 0) ? *(const PG8_LAS f32x4*)(X + ((sp * 2 + (fr & 1)) * 256 + bj * HALF + colh + 4 * n)) : (f32x4){0.f, 0.f, 0.f, 0.f};
#pragma unroll
            for (int m = 0; m < 4; ++m) {
                f32x4 cv[2][2];
#pragma unroll
                for (int bj = 0; bj < 2; ++bj)
#pragma unroll
                    for (int n = 0; n < 2; ++n) { const f32x4 v = acc[ai][bj][m][n]; const f32x4 pp = (m == 0) ? pv[bj][n] : acc[ai][bj][m > 0 ? m - 1 : 0][n]; f32x4 p1, p2;
#pragma unroll
                        for (int j = 0; j < 4; ++j) { p1[j] = dpp_mov<0x111>(dpp_rot<0x121>(pp[j]), v[j]); p2[j] = dpp_mov<0x112>(dpp_rot<0x122>(pp[j]), v[j]); }
                        cv[bj][n] = bb[bj][n] + w0[bj][n] * p2 + w1[bj][n] * p1 + w2[bj][n] * v; }
                const f32x4 o0 = gelu_v4(cv[0][0]) * cv[1][0], o1 = gelu_v4(cv[0][1]) * cv[1][1];
                u32x4 w; w.x = cvt_pk_bf16(o0[0], o0[1]); w.y = cvt_pk_bf16(o0[2], o0[3]); w.z = cvt_pk_bf16(o1[0], o1[1]); w.w = cvt_pk_bf16(o1[2], o1[3]);
                const int row = u.pm * BM + ai * HALF + wr * 64 + m * 16 + fr;
                if (!(ai == 0 && m == 0 && wr == 0 && fr < 2)) *(u32x4*)(ACT + (size_t)row * UPF + ca) = w;
            }
        }
    }
};
struct FixOrder : StaticOrder {
    bf16_t* ACT; const float* RAWB; const float* cw; const float* cb;
    __device__ __forceinline__ void a_ready(const Unit& u) const {
        for (int ch = threadIdx.x; ch < 2 * (UPF / 8); ch += 512) { const int r = ch / (UPF / 8), q8 = (ch % (UPF / 8)) * 8;
            f32x4 a0 = *(const f32x4*)(cb + q8), a1 = *(const f32x4*)(cb + q8 + 4), g0 = *(const f32x4*)(cb + UPF + q8), g1 = *(const f32x4*)(cb + UPF + q8 + 4);
#pragma unroll
            for (int k = 0; k < 3; ++k) { const int rr = r - 2 + k;
                if (rr >= 0 || u.pm > 0) { const float* src = RAWB + (size_t)(rr >= 0 ? u.pm * 4 + rr : (u.pm - 1) * 4 + 4 + rr) * UPF2; const float* wk = cw + k * UPF2;
                    a0 += *(const f32x4*)(wk + q8) * *(const f32x4*)(src + q8); a1 += *(const f32x4*)(wk + q8 + 4) * *(const f32x4*)(src + q8 + 4);
                    g0 += *(const f32x4*)(wk + UPF + q8) * *(const f32x4*)(src + UPF + q8); g1 += *(const f32x4*)(wk + UPF + q8 + 4) * *(const f32x4*)(src + UPF + q8 + 4); } }
            u32x4 w; w.x = cvt_pk_bf16(gelu_tanh_f(a0[0]) * g0[0], gelu_tanh_f(a0[1]) * g0[1]); w.y = cvt_pk_bf16(gelu_tanh_f(a0[2]) * g0[2], gelu_tanh_f(a0[3]) * g0[3]);
            w.z = cvt_pk_bf16(gelu_tanh_f(a1[0]) * g1[0], gelu_tanh_f(a1[1]) * g1[1]); w.w = cvt_pk_bf16(gelu_tanh_f(a1[2]) * g1[2], gelu_tanh_f(a1[3]) * g1[3]);
            *(u32x4*)(ACT + (size_t)(u.pm * BM + r) * UPF + q8) = w; }
        asm volatile("s_waitcnt vmcnt(0)" ::: "memory"); __builtin_amdgcn_s_barrier(); asm volatile("" ::: "memory");
    }
};

struct PanelSS {
    unsigned* xbuf;
    unsigned* cnt;
    unsigned* tmo;
    float eps;
    __device__ __forceinline__ void run(const f32x4 (&v)[2][2][4][2], const Unit& u, int wr, int wc, int fr, int fq, PG8_LAS unsigned char* lds, int wid, int lane) const {
        PG8_LAS float* P = (PG8_LAS float*)lds;
        PG8_LAS float* S = (PG8_LAS float*)(lds + 8192);
#pragma unroll
        for (int ai = 0; ai < 2; ++ai)
#pragma unroll
            for (int m = 0; m < 4; ++m) { float q = 0.f;
#pragma unroll
                for (int bj = 0; bj < 2; ++bj)
#pragma unroll
                    for (int n = 0; n < 2; ++n) { const f32x4 x = v[ai][bj][m][n]; q += (x[0] * x[0] + x[1] * x[1]) + (x[2] * x[2] + x[3] * x[3]); }
                q += __shfl_xor(q, 16); q += __shfl_xor(q, 32);
                if (fq == 0) P[(ai * HALF + wr * 64 + m * 16 + fr) * 4 + wc] = q; }
        asm volatile("s_waitcnt lgkmcnt(0)" ::: "memory"); __builtin_amdgcn_s_barrier(); asm volatile("" ::: "memory");
        const int row = wid * 32 + (lane & 31);
        if (lane < 32) { const float q = (P[row * 4 + 0] + P[row * 4 + 1]) + (P[row * 4 + 2] + P[row * 4 + 3]);
            __hip_atomic_store(xbuf + ((size_t)(u.pm * BM + row) * 8 + u.pn), __builtin_bit_cast(unsigned, q), __ATOMIC_RELAXED, __HIP_MEMORY_SCOPE_AGENT); }
        asm volatile("s_waitcnt vmcnt(0)" ::: "memory");
        if (lane == 0) __hip_atomic_fetch_add(cnt + 64 * u.pm, 1u, __ATOMIC_RELAXED, __HIP_MEMORY_SCOPE_AGENT);
        if (wid == 0) {
            unsigned sp = 0;
            while ((unsigned)__builtin_amdgcn_readfirstlane(__hip_atomic_load(cnt + 64 * u.pm, __ATOMIC_RELAXED, __HIP_MEMORY_SCOPE_AGENT)) < 64u) {
                __builtin_amdgcn_s_sleep(2);
                if (++sp > (1u << 20)) { if (lane == 0) __hip_atomic_store(tmo, 1u, __ATOMIC_RELAXED, __HIP_MEMORY_SCOPE_AGENT); break; } }
            asm volatile("" ::: "memory");
        }
        asm volatile("s_waitcnt vmcnt(0) lgkmcnt(0)" ::: "memory"); __builtin_amdgcn_s_barrier(); asm volatile("" ::: "memory");
        if (lane < 32) { const unsigned* slot = xbuf + (size_t)(u.pm * BM + row) * 8; float q = 0.f;
#pragma unroll
            for (int t = 0; t < 8; ++t) q += __builtin_bit_cast(float, __hip_atomic_load(slot + t, __ATOMIC_RELAXED, __HIP_MEMORY_SCOPE_AGENT));
            S[row] = 1.0f / sqrtf(q * (1.0f / 2048.0f) + eps); }
        asm volatile("s_waitcnt lgkmcnt(0)" ::: "memory"); __builtin_amdgcn_s_barrier(); asm volatile("" ::: "memory");
    }
};
struct EpiMixFused {
    static constexpr bool PERM = true, AFTER_DRAIN = true; static constexpr int MIDK = 0;
    const float* x; bf16_t* X1B; bf16_t* H2; const float* vec; PanelSS st1, st2;
    __device__ __forceinline__ void mid(f32x4 (&)[2][2][4][2], const Unit&, int, int, int, int) const {}
    __device__ __forceinline__ void operator()(const f32x4 (&)[2][2][4][2], const Unit&, int, int, int, int) const {}
    __device__ __forceinline__ void fused(f32x4 (&acc)[2][2][4][2], const Unit& u, int wr, int wc, int fr, int fq, PG8_LAS unsigned char* lds, int wid, int lane) const {
        const PG8_LAS float* S = (const PG8_LAS float*)(lds + 8192);
        const int col0 = u.pn * BM + wc * 32 + 8 * fq;
        st1.run(acc, u, wr, wc, fr, fq, lds, wid, lane);
        { f32x4 g1[2][2];
#pragma unroll
          for (int bj = 0; bj < 2; ++bj)
#pragma unroll
            for (int n = 0; n < 2; ++n) g1[bj][n] = *(const f32x4*)(vec + col0 + bj * HALF + n * 4);
#pragma unroll
          for (int ai = 0; ai < 2; ++ai)
#pragma unroll
            for (int m = 0; m < 4; ++m) { const int r = ai * HALF + wr * 64 + m * 16 + fr; const float rs = S[r]; const size_t off = (size_t)(u.pm * BM + r) * 2048 + col0;
#pragma unroll
                for (int bj = 0; bj < 2; ++bj) { const f32x4 xa = __builtin_nontemporal_load((const f32x4*)(x + off + bj * HALF)), xb = __builtin_nontemporal_load((const f32x4*)(x + off + bj * HALF + 4));
                    const f32x4 x1a = xa + g1[bj][0] * (acc[ai][bj][m][0] * rs), x1b = xb + g1[bj][1] * (acc[ai][bj][m][1] * rs);
                    acc[ai][bj][m][0] = x1a; acc[ai][bj][m][1] = x1b;
                    u32x4 o; o.x = cvt_pk_bf16(x1a[0], x1a[1]); o.y = cvt_pk_bf16(x1a[2], x1a[3]); o.z = cvt_pk_bf16(x1b[0], x1b[1]); o.w = cvt_pk_bf16(x1b[2], x1b[3]);
                    *(u32x4*)(X1B + off + bj * HALF) = o; }
                asm volatile("" ::: "memory"); } }
        st2.run(acc, u, wr, wc, fr, fq, lds, wid, lane);
        { f32x4 a2[2][2], b2[2][2];
#pragma unroll
          for (int bj = 0; bj < 2; ++bj)
#pragma unroll
            for (int n = 0; n < 2; ++n) { a2[bj][n] = *(const f32x4*)(vec + 2048 + col0 + bj * HALF + n * 4); b2[bj][n] = *(const f32x4*)(vec + 4096 + col0 + bj * HALF + n * 4); }
#pragma unroll
          for (int ai = 0; ai < 2; ++ai)
#pragma unroll
            for (int m = 0; m < 4; ++m) { const int r = ai * HALF + wr * 64 + m * 16 + fr; const float rs = S[r]; const size_t off = (size_t)(u.pm * BM + r) * 2048 + col0;
#pragma unroll
                for (int bj = 0; bj < 2; ++bj) { const f32x4 ha = acc[ai][bj][m][0] * rs * a2[bj][0] + b2[bj][0], hb = acc[ai][bj][m][1] * rs * a2[bj][1] + b2[bj][1];
                    u32x4 o; o.x = cvt_pk_bf16(ha[0], ha[1]); o.y = cvt_pk_bf16(ha[2], ha[3]); o.z = cvt_pk_bf16(hb[0], hb[1]); o.w = cvt_pk_bf16(hb[2], hb[3]);
                    *(u32x4*)(H2 + off + bj * HALF) = o; } } }
    }
};
struct EpiOutFused {
    static constexpr bool PERM = true, AFTER_DRAIN = true; static constexpr int MIDK = 0;
    const bf16_t* X1B; float* out; const float* vec; PanelSS st;
    __device__ __forceinline__ void mid(f32x4 (&)[2][2][4][2], const Unit&, int, int, int, int) const {}
    __device__ __forceinline__ void operator()(const f32x4 (&)[2][2][4][2], const Unit&, int, int, int, int) const {}
    __device__ __forceinline__ void fused(f32x4 (&acc)[2][2][4][2], const Unit& u, int wr, int wc, int fr, int fq, PG8_LAS unsigned char* lds, int wid, int lane) const {
        const PG8_LAS float* S = (const PG8_LAS float*)(lds + 8192);
        const int col0 = u.pn * BM + wc * 32 + 8 * fq;
        st.run(acc, u, wr, wc, fr, fq, lds, wid, lane);
        f32x4 g2[2][2];
#pragma unroll
        for (int bj = 0; bj < 2; ++bj)
#pragma unroll
            for (int n = 0; n < 2; ++n) g2[bj][n] = *(const f32x4*)(vec + 3 * 2048 + col0 + bj * HALF + n * 4);
#pragma unroll
        for (int ai = 0; ai < 2; ++ai)
#pragma unroll
            for (int m = 0; m < 4; ++m) { const int r = ai * HALF + wr * 64 + m * 16 + fr; const float rs = S[r]; const size_t off = (size_t)(u.pm * BM + r) * 2048 + col0;
#pragma unroll
                for (int bj = 0; bj < 2; ++bj) { const u32x4 xb = __builtin_nontemporal_load((const u32x4*)(X1B + off + bj * HALF));
                    const f32x4 xa = (f32x4){bf_lo(xb.x), bf_hi(xb.x), bf_lo(xb.y), bf_hi(xb.y)}, xc = (f32x4){bf_lo(xb.z), bf_hi(xb.z), bf_lo(xb.w), bf_hi(xb.w)};
                    __builtin_nontemporal_store(xa + g2[bj][0] * (acc[ai][bj][m][0] * rs), (f32x4*)(out + off + bj * HALF)); __builtin_nontemporal_store(xc + g2[bj][1] * (acc[ai][bj][m][1] * rs), (f32x4*)(out + off + bj * HALF + 4)); }
                asm volatile("" ::: "memory"); }
    }
};

template <class Epi, class Sched, bool ALIGN_EPI = false, bool SP2 = false, int EPI_S = 0>
__device__ __forceinline__ void gemm_phase(PG8_LAS unsigned char* lds, const Gemm g, const Sched& S, const Epi& E) {
    const int tid = threadIdx.x, wid = __builtin_amdgcn_readfirstlane(tid >> 6), lane = tid & 63, wr = wid >> 2, wc = wid & 3, fr = lane & 15, fq = lane >> 4;
    const int K = g.K, nt = K / BK;
    unsigned voffA[2], voffB[2];
#pragma unroll
    for (int i = 0; i < 2; ++i) { int R, C; stage_rc(tid * 16 + i * 8192, R, C); const int Rb = Epi::PERM ? ((R & ~31) + perm32(R & 31)) : R;
        voffA[i] = (unsigned)(R * K + C) * 2u; voffB[i] = (unsigned)(Rb * K + C) * 2u; }
    const size_t kstep = (size_t)(BK * 2);
    const size_t hstep = (size_t)HALF * K * 2;
    const size_t tstep = 2 * hstep;
    const size_t hstepB = g.b_hstep ? g.b_hstep : hstep, tstepB = g.b_tstep ? g.b_tstep : tstep;
    const unsigned ldsw = (unsigned)wid * 1024u;
    const int aoff = lds_byte(wr * 64 + fr, fq * 8), boff = lds_byte(wc * 32 + fr, fq * 8);
#define PG8_SA(b, h) (((b) * 2 + (h)) * HTB)
#define PG8_SB(b, h) ((4 + (b) * 2 + (h)) * HTB)
#define PG8_STAGE(bufoff, gbase, voff) do { _Pragma("unroll") for (int _i = 0; _i < 2; ++_i) \
        __builtin_amdgcn_raw_ptr_buffer_load_lds((&(voff)[0] == &voffA[0]) ? rsA : rsB, (PG8_LAS void*)(lds + (bufoff) + ldsw + _i * 8192), 16, (int)(voff)[_i], (int)(gbase), 0, 0); } while (0)
#define PG8_LDA(dst, b, h) do { _Pragma("unroll") for (int m = 0; m < 4; ++m) _Pragma("unroll") for (int k = 0; k < 2; ++k) dst[m][k] = *(const PG8_LAS bf16x8*)(lds + PG8_SA(b, h) + aoff + m * 2048 + k * 1024); } while (0)
#define PG8_LDB(dst, b, h) do { _Pragma("unroll") for (int n = 0; n < 2; ++n) _Pragma("unroll") for (int k = 0; k < 2; ++k) dst[n][k] = *(const PG8_LAS bf16x8*)(lds + PG8_SB(b, h) + boff + n * 2048 + k * 1024); } while (0)
#define PG8_MMA(ai, bj, At, Bt) do { __builtin_amdgcn_s_setprio(1); _Pragma("unroll") for (int m = 0; m < 4; ++m) _Pragma("unroll") for (int n = 0; n < 2; ++n) _Pragma("unroll") for (int k = 0; k < 2; ++k) \
        acc[ai][bj][m][n] = __builtin_amdgcn_mfma_f32_16x16x32_bf16(Bt[n][k], At[m][k], acc[ai][bj][m][n], 0, 0, 0); __builtin_amdgcn_s_setprio(0); } while (0)
#define PG8_WAIT_V(n) asm volatile("s_waitcnt vmcnt(" #n ")" ::: "memory")
#define PG8_WAIT_VN(n) asm volatile("s_waitcnt vmcnt(%0)" :: "i"(n) : "memory")
#define PG8_WAIT_L(n) asm volatile("s_waitcnt lgkmcnt(" #n ")" ::: "memory")
#define PG8_BAR __builtin_amdgcn_s_barrier()
#define PG8_SCHED __builtin_amdgcn_sched_barrier(0)
    Unit cur, nxt; int ui = 0;
    [[maybe_unused]] bool fa = false;
    if (!S.next(0, cur)) return;
    f32x4 acc[2][2][4][2];
#pragma unroll
    for (int a = 0; a < 2; ++a)
#pragma unroll
        for (int b = 0; b < 2; ++b)
#pragma unroll
            for (int m = 0; m < 4; ++m)
#pragma unroll
                for (int n = 0; n < 2; ++n) acc[a][b][m][n] = (f32x4){0.f, 0.f, 0.f, 0.f};
    bf16x8 At[4][2], B0[2][2], B1[2][2];
    const __amdgpu_buffer_rsrc_t rsA = __builtin_amdgcn_make_buffer_rsrc((void*)g.A, 0, (int)((size_t)g.M * K * 2), 0x00020000), rsB = __builtin_amdgcn_make_buffer_rsrc((void*)g.Bt, 0, (int)((size_t)g.N * K * 2), 0x00020000);
    unsigned cA = (unsigned)((size_t)cur.pm * tstep), cB = (unsigned)((size_t)cur.pn * tstepB);
    S.a_ready(cur);
    if constexpr (SP2) {
        PG8_STAGE(PG8_SB(0, 0), cB, voffB); PG8_STAGE(PG8_SB(0, 1), cB + hstepB, voffB); PG8_STAGE(PG8_SA(0, 0), cA, voffA); PG8_STAGE(PG8_SA(0, 1), cA + hstep, voffA);
        if (wr == 1) PG8_BAR;
        PG8_WAIT_V(2); PG8_BAR;
        PG8_STAGE(PG8_SB(1, 0), cB + kstep, voffB); PG8_STAGE(PG8_SB(1, 1), cB + hstepB + kstep, voffB);
        PG8_WAIT_V(6); PG8_BAR;
    } else {
        PG8_STAGE(PG8_SB(0, 0), cB, voffB); PG8_STAGE(PG8_SA(0, 0), cA, voffA); PG8_STAGE(PG8_SB(0, 1), cB + hstepB, voffB); PG8_STAGE(PG8_SA(0, 1), cA + hstep, voffA);
        if (wr == 1) PG8_BAR;
        PG8_WAIT_V(4); PG8_BAR;
        PG8_STAGE(PG8_SB(1, 0), cB + kstep, voffB); PG8_STAGE(PG8_SA(1, 0), cA + kstep, voffA); PG8_STAGE(PG8_SB(1, 1), cB + hstepB + kstep, voffB);
        PG8_WAIT_V(6); PG8_BAR;
    }
    for (;;) {
        const bool has_next = S.next(ui + 1, nxt);
        const unsigned nA = has_next ? (unsigned)((size_t)nxt.pm * tstep) : cA, nB = has_next ? (unsigned)((size_t)nxt.pn * tstepB) : cB;
        for (int tb = 0; tb < nt; ) {
        const int te = (Epi::MIDK > 0 && tb < Epi::MIDK) ? Epi::MIDK : nt;
        if constexpr (Epi::MIDK > 0) { if (tb == Epi::MIDK) E.mid(acc, cur, wr, wc, fr, fq); }
#define PG8_KBODY(V1, V2, V3, DO_A1) { \
            const bool last = (t == nt - 2); \
            const unsigned a1 = cA + (unsigned)((t + 1) * kstep); \
            const unsigned a2 = last ? nA : cA + (unsigned)((t + 2) * kstep), b2 = last ? nB : cB + (unsigned)((t + 2) * kstep); \
            const unsigned b3 = b2 + (unsigned)kstep; \
            if (last && has_next) S.a_ready(nxt); \
              \
            PG8_LDB(B0, 0, 0); PG8_LDB(B1, 0, 1); PG8_SCHED; PG8_LDA(At, 0, 0); if (DO_A1) { PG8_STAGE(PG8_SA(1, 0), a1, voffA); PG8_STAGE(PG8_SA(1, 1), a1 + hstep, voffA); } \
            PG8_WAIT_VN(V1); PG8_WAIT_L(0); PG8_BAR; PG8_MMA(0, 0, At, B0); PG8_MMA(0, 1, At, B1); PG8_BAR; PG8_SCHED; \
              \
            PG8_LDA(At, 0, 1); PG8_STAGE(PG8_SB(0, 0), b2, voffB); PG8_STAGE(PG8_SB(0, 1), b2 + hstepB, voffB); \
            PG8_WAIT_VN(V2); PG8_WAIT_L(0); PG8_BAR; PG8_MMA(1, 0, At, B0); PG8_MMA(1, 1, At, B1); PG8_BAR; PG8_SCHED; \
              \
            PG8_LDB(B0, 1, 0); PG8_LDB(B1, 1, 1); PG8_SCHED; PG8_LDA(At, 1, 0); PG8_STAGE(PG8_SA(0, 0), a2, voffA); PG8_STAGE(PG8_SA(0, 1), a2 + hstep, voffA); \
            PG8_WAIT_VN(V3); PG8_WAIT_L(0); PG8_BAR; PG8_MMA(0, 0, At, B0); PG8_MMA(0, 1, At, B1); PG8_BAR; PG8_SCHED; \
              \
            PG8_LDA(At, 1, 1); PG8_STAGE(PG8_SB(1, 0), b3, voffB); PG8_STAGE(PG8_SB(1, 1), b3 + hstepB, voffB); \
            PG8_WAIT_VN(6); PG8_WAIT_L(0); PG8_BAR; PG8_MMA(1, 0, At, B0); PG8_MMA(1, 1, At, B1); PG8_BAR; PG8_SCHED; }
        static_assert(SP2, "this body keeps only the two-super-phase K-loop");
        int t = tb;
        if constexpr (EPI_S > 0) { if (fa && t == 0 && te >= 2) { PG8_KBODY(8 + EPI_S, 6 + EPI_S, 8 + EPI_S, false); t = 2; } }
        for (; t < te; t += 2) PG8_KBODY(8, 6, 8, true);
        tb = te; }
        if constexpr (ALIGN_EPI) { if (wr == 0) PG8_BAR; }
        if constexpr (EPI_S > 0 && ALIGN_EPI) { fa = has_next; if (has_next) { PG8_STAGE(PG8_SA(1, 0), nA + kstep, voffA); PG8_STAGE(PG8_SA(1, 1), nA + kstep + hstep, voffA); PG8_WAIT_VN(4); } }
        if constexpr (!Epi::AFTER_DRAIN) { E(acc, cur, wr, wc, fr, fq); S.done(cur); }
        if (!has_next) break;
#pragma unroll
        for (int a = 0; a < 2; ++a)
#pragma unroll
            for (int b = 0; b < 2; ++b)
#pragma unroll
                for (int m = 0; m < 4; ++m)
#pragma unroll
                    for (int n = 0; n < 2; ++n) acc[a][b][m][n] = (f32x4){0.f, 0.f, 0.f, 0.f};
        cur = nxt; cA = nA; cB = nB; ++ui;
        if constexpr (ALIGN_EPI) { if (wr == 1) PG8_BAR; }
    }
    PG8_WAIT_V(0);
    if constexpr (!ALIGN_EPI) { if (wr == 0) PG8_BAR; }
    PG8_BAR;
    if constexpr (Epi::AFTER_DRAIN) { E.fused(acc, cur, wr, wc, fr, fq, lds, wid, lane); S.done(cur); }
#undef PG8_SA
#undef PG8_SB
#undef PG8_STAGE
#undef PG8_LDA
#undef PG8_LDB
#undef PG8_MMA
#undef PG8_WAIT_VN
#undef PG8_KBODY
#undef PG8_WAIT_V
#undef PG8_WAIT_L
#undef PG8_BAR
#undef PG8_SCHED
}
}
#define GAS __attribute__((address_space(1)))
#define LAS __attribute__((address_space(3)))
typedef unsigned short bf16;
typedef unsigned v4u __attribute__((ext_vector_type(4)));
typedef float f32x4 __attribute__((ext_vector_type(4)));
typedef short bf16x8 __attribute__((ext_vector_type(8)));
typedef GAS unsigned gu32;
typedef GAS unsigned long long gu64;
#define RLX_AGENT __ATOMIC_RELAXED, __HIP_MEMORY_SCOPE_AGENT
#define LDS_WAIT() asm volatile("s_waitcnt lgkmcnt(0)" ::: "memory")
#define VM_WAIT() asm volatile("s_waitcnt vmcnt(0)" ::: "memory")
__device__ __forceinline__ unsigned long long rt() { return __builtin_amdgcn_s_memrealtime(); }
__device__ __forceinline__ unsigned f2bf(float f) { unsigned u = __builtin_bit_cast(unsigned, f); return (u + 0x7fffu + ((u >> 16) & 1u)) >> 16; }
__device__ __forceinline__ unsigned pk2(float lo, float hi) { return f2bf(lo) | (f2bf(hi) << 16); }

#define XB_TMO      128
#define XB_XCNT(j)  (256  + 64 * (j))
#define XB_XSUB(j)  (1280 + 64 * (j))
#define XB_XGEN(j)  (2304 + 64 * (j))
#define XB_TOP      3328
#define XB_TOPGEN   3392
#define XCD_BAR_WORDS 3456
#define XB_SPIN_CAP (1u << 18)

__device__ __forceinline__ unsigned xb_ld(unsigned* p)              { return __hip_atomic_load(p, __ATOMIC_RELAXED, __HIP_MEMORY_SCOPE_AGENT); }
__device__ __forceinline__ unsigned xb_add(unsigned* p, unsigned v) { return __hip_atomic_fetch_add(p, v, __ATOMIC_RELAXED, __HIP_MEMORY_SCOPE_AGENT); }
__device__ __forceinline__ unsigned xb_xcc_id() { return (unsigned)__builtin_amdgcn_s_getreg((3 << 11) | 20) & 0xFu; }
#define XB_SPIN(cond, bar) do { unsigned _sp = 0; while (cond) { __builtin_amdgcn_s_sleep(1); \
    if ((++_sp & 255u) == 0u) { if (xb_ld(&(bar)[XB_TMO])) break; if (_sp > XB_SPIN_CAP) { atomicAdd(&(bar)[XB_TMO], 1u); break; } } } } while (0)

struct XcdBarrier {
    unsigned* bar; unsigned x;
    volatile LAS unsigned* st;
};

__device__ __forceinline__ XcdBarrier xcd_barrier_post(unsigned* bar, volatile LAS unsigned* st) {
    XcdBarrier b; b.bar = bar; b.x = xb_xcc_id(); b.st = st;
    if (threadIdx.x == 0) (void)xb_add(&bar[XB_XCNT(b.x)], 1u);
    return b;
}
__device__ __forceinline__ void xcd_barrier_complete(unsigned* bar, unsigned x, unsigned& nloc, unsigned& nx) {
    const unsigned G = gridDim.x * gridDim.y * gridDim.z;
    unsigned sum, cnt, mine, sp = 0u;
    for (;;) {
        sum = 0u; cnt = 0u; mine = 0u;
#pragma unroll
        for (unsigned j = 0; j < 16; ++j) { const unsigned c = xb_ld(&bar[XB_XCNT(j)]); sum += c; cnt += (c > 0u) ? 1u : 0u; mine = (j == x) ? c : mine; }
        if (sum == G) break;
        __builtin_amdgcn_s_sleep(1);
        if ((++sp & 255u) == 0u) { if (xb_ld(&bar[XB_TMO])) break; if (sp > XB_SPIN_CAP) { atomicAdd(&bar[XB_TMO], 1u); break; } }
    }
    nloc = mine > 0u ? mine : 1u; nx = cnt > 0u ? cnt : 1u;
}

__device__ __forceinline__ void xcd_barrier(const XcdBarrier& b) {
    asm volatile("s_waitcnt vmcnt(0)" ::: "memory");
    __syncthreads();
    if (threadIdx.x == 0) {
        unsigned* bar = b.bar;
        __builtin_amdgcn_s_waitcnt(0);
        unsigned nloc = b.st[0], nx = b.st[1];
        if (nloc == 0u) { xcd_barrier_complete(bar, b.x, nloc, nx); b.st[0] = nloc; b.st[1] = nx; }
        const unsigned old = xb_add(&bar[XB_XSUB(b.x)], 1u);
        const unsigned gen = old / nloc;
        if (old + 1u == (gen + 1u) * nloc) {
            __builtin_amdgcn_fence(__ATOMIC_RELEASE, "agent");
            asm volatile("s_waitcnt vmcnt(0)" ::: "memory");
            const unsigned og = xb_add(&bar[XB_TOP], 1u);
            const unsigned tg = og / nx;
            const bool last_xcd = (og + 1u == (tg + 1u) * nx);
            if (last_xcd) xb_add(&bar[XB_TOPGEN], 1u);
            asm volatile("buffer_inv sc1" ::: "memory");
            if (!last_xcd) XB_SPIN(xb_ld(&bar[XB_TOPGEN]) == tg, bar);
            asm volatile("" ::: "memory");
            xb_add(&bar[XB_XGEN(b.x)], 1u);
            asm volatile("s_waitcnt vmcnt(0)" ::: "memory");
        } else {
            asm volatile("buffer_inv sc1" ::: "memory");
            XB_SPIN(xb_ld(&bar[XB_XGEN(b.x)]) == gen, bar);
            asm volatile("s_waitcnt vmcnt(0)" ::: "memory");
        }
    }
    __syncthreads();
}

#ifndef MK_N_LAUNCHES
#define MK_N_LAUNCHES 1
#endif
constexpr int NWAVES = 8, NPHASES = 10;
constexpr int N_LAUNCHES = MK_N_LAUNCHES;
constexpr int SEQ = 8192, DM = 2048, AW = 2048, BW = 1024, INC = 9216, FF = 5632, FF2 = 11264, NMOD = 12288, KAB = 3072;
constexpr float EPS = 1e-6f;
constexpr size_t MiB = 1u << 20;
constexpr size_t WS_CTL = 0, CTL_ZERO_BYTES = 1 * MiB;
constexpr size_t WS_MOD = 64 * 1024, WS_STATS = 128 * 1024;
constexpr size_t WS_CNT = 192 * 1024;
constexpr size_t WS_XBUF = 1 * MiB + 128 * 1024;
constexpr size_t WS_VEC = 1 * MiB;
constexpr size_t WS_WIN = 2 * MiB, WS_WAB = 38 * MiB, WS_WOUT = 50 * MiB, WS_WUP = 58 * MiB, WS_WDN = 102 * MiB, WS_WPOOL = 124 * MiB, WS_WSP = WS_WPOOL + 512 * 1024;
constexpr size_t WS_H1 = 125 * MiB, WS_U = 157 * MiB, WS_V = 189 * MiB, WS_P = 221 * MiB, WS_GA = 237 * MiB, WS_GB = 269 * MiB;
constexpr size_t WS_SGPB = 301 * MiB, WS_MERGED = 349 * MiB, WS_MIX = 125 * MiB, WS_H2 = 301 * MiB, WS_ACT = 125 * MiB, WS_Y = 213 * MiB;
constexpr size_t WS_RAWB = 389 * MiB;
constexpr size_t WS_END = 395 * MiB;
constexpr int CW_BAR = 4096;
static_assert((CW_BAR + XCD_BAR_WORDS) * 4 <= (int)WS_MOD && WS_MOD + NMOD * 4 <= WS_STATS && WS_STATS + SEQ * 8 <= WS_CNT && WS_CNT + 3 * 32 * 256 <= CTL_ZERO_BYTES && WS_XBUF + 3 * 256 * 1024 <= 2 * MiB, "CTL map");
constexpr int RING_OFF = 0, RING_BYTES = 131072, LDSCTL_OFF = RING_BYTES, MISC_OFF = LDSCTL_OFF + 320, XCH_OFF = RING_BYTES + 1024, LDS_BYTES = 147456;

typedef unsigned v2u __attribute__((ext_vector_type(2)));
__device__ __forceinline__ float wave_sum(float v) {
#pragma unroll
    for (int o = 1; o < 64; o <<= 1) v += __shfl_xor(v, o);
    return v;
}
__device__ __forceinline__ float sigm(float z) { return __builtin_amdgcn_rcpf(1.0f + __builtin_amdgcn_exp2f(z * -1.44269504089f)); }
__device__ __forceinline__ float gelu_t(float x) { const float z = x * (1.5957691216f + 0.0713548163f * x * x); return x * sigm(z); }
__device__ __forceinline__ float bflo(unsigned w) { return __builtin_bit_cast(float, w << 16); }
__device__ __forceinline__ float bfhi(unsigned w) { return __builtin_bit_cast(float, w & 0xffff0000u); }

__device__ __forceinline__ void p0_mod_gemv(const float* c, const float* w_ada, const float* b_ada, float* MOD, LAS unsigned char* lds, int vcu, int G, int tid, int lane, int wave) {
    constexpr int NCG = NMOD / 256, NKR = DM / 128;
    LAS float* red = (LAS float*)lds;
    for (int it = vcu; it < NCG * NKR; it += G) {
        const int cg = it % NCG, kr = it / NCG, k0 = kr * 128 + wave * 16, col = cg * 256 + lane * 4;
        float cv = c[k0 + (lane & 15)]; cv = cv * sigm(cv);
        f32x4 a = (f32x4){0.f, 0.f, 0.f, 0.f};
#pragma unroll
        for (int kk = 0; kk < 16; ++kk) { const float s = __shfl(cv, kk); const f32x4 w = __builtin_nontemporal_load((const f32x4*)(w_ada + (size_t)(k0 + kk) * NMOD + col)); a += w * s; }
        *(LAS f32x4*)(red + wave * 256 + lane * 4) = a;
        __syncthreads();
        if (tid < 256) { float s = 0.f;
#pragma unroll
            for (int w = 0; w < 8; ++w) s += red[w * 256 + tid];
            if (kr == 0) s += b_ada[cg * 256 + tid];
            atomicAdd(MOD + cg * 256 + tid, s); }
        __syncthreads();
    }
}
struct TrDesc { const float* W; bf16* WT; int N, dpitch, koff, item; };
__device__ __forceinline__ void tr_load(const TrDesc& d, int lane, float (&tmp)[32]) {
    const int nblk = d.N / 32, kb = d.item / nblk, nb = d.item % nblk, k0 = 64 * kb, n0 = 32 * nb;
    const float* src = d.W + (size_t)(k0 + (lane >> 5)) * d.N + n0 + (lane & 31);
#pragma unroll
    for (int i = 0; i < 32; ++i) tmp[i] = __builtin_nontemporal_load(src + (size_t)(2 * i) * d.N);
}
__device__ __forceinline__ void tr_store(const TrDesc& d, const float (&tmp)[32], LAS float* scr, int lane) {
    const int nblk = d.N / 32, kb = d.item / nblk, nb = d.item % nblk, k0 = 64 * kb, n0 = 32 * nb;
#pragma unroll
    for (int i = 0; i < 32; ++i) scr[(2 * i + (lane >> 5)) * 33 + (lane & 31)] = tmp[i];
    LDS_WAIT(); asm volatile("" ::: "memory");
    const int c = lane & 7;
#pragma unroll
    for (int j = 0; j < 4; ++j) { const int n = (lane >> 3) + 8 * j; const LAS float* s = scr + (8 * c) * 33 + n;
        v4u o; o.x = pg8::cvt_pk_bf16(s[0 * 33], s[1 * 33]); o.y = pg8::cvt_pk_bf16(s[2 * 33], s[3 * 33]); o.z = pg8::cvt_pk_bf16(s[4 * 33], s[5 * 33]); o.w = pg8::cvt_pk_bf16(s[6 * 33], s[7 * 33]);
        *(v4u*)(d.WT + (size_t)(n0 + n) * d.dpitch + d.koff + k0 + 8 * c) = o; }
    LDS_WAIT(); asm volatile("" ::: "memory");
}
template <class L> __device__ __forceinline__ void convert_list(const L& list, int n, int start, int stride, LAS float* scr, int lane) {
    float ta[32], tb[32]; TrDesc da, db; int it = start;
    if (it < n) { da = list.get(it); tr_load(da, lane, ta); }
    while (it < n) {
        int it2 = it + stride; if (it2 < n) { db = list.get(it2); tr_load(db, lane, tb); }
        tr_store(da, ta, scr, lane);
        it = it2; if (it >= n) break;
        it2 = it + stride; if (it2 < n) { da = list.get(it2); tr_load(da, lane, ta); }
        tr_store(db, tb, scr, lane);
        it = it2;
    }
}
struct ListOne { const float* W; bf16* WT; int N, dpitch, koff, first; __device__ __forceinline__ TrDesc get(int r) const { return TrDesc{W, WT, N, dpitch, koff, first + r}; } };
struct ListP0 {
    const float *win, *wpool; bf16 *Win_t, *WpT;
    static constexpr int I_IN = (DM / 64) * (INC / 32), I_P = (256 / 64) * (256 / 32), NITEMS = I_IN + 4 * I_P;
    __device__ __forceinline__ TrDesc get(int r) const {
        if (r < I_IN) return TrDesc{win, Win_t, INC, DM, 0, r}; r -= I_IN;
        const int gi = r / I_P; return TrDesc{wpool + (size_t)gi * 65536, WpT + (size_t)gi * 65536, 256, 256, 0, r % I_P};
    }
};
struct ListP2 {
    const float *wa, *wb, *wout, *wup; bf16 *Wab_t, *Wout_t, *Wup_t;
    static constexpr int I_A = (AW / 64) * (DM / 32), I_B = (BW / 64) * (DM / 32), I_O = (DM / 64) * (DM / 32), I_U = (DM / 64) * (FF2 / 32), NITEMS = I_A + I_B + I_O + I_U;
    __device__ __forceinline__ TrDesc get(int r) const {
        if (r < I_A) return TrDesc{wa, Wab_t, DM, KAB, 0, r}; r -= I_A;
        if (r < I_B) return TrDesc{wb, Wab_t, DM, KAB, AW, r}; r -= I_B;
        if (r < I_O) return TrDesc{wout, Wout_t, DM, DM, 0, r}; r -= I_O;
        return TrDesc{wup, Wup_t, FF2, DM, 0, r};
    }
};

typedef short v4s __attribute__((ext_vector_type(4)));
__device__ __forceinline__ void p3_spatial(LAS unsigned char* lds, int n, int h, const bf16* V, const bf16* U, const float* stats, const float* ln_g, const float* ln_b,
                                           const bf16* Wsp, const float* b_sp, bf16* SGPB, int tid, int lane, int wave) {
    LAS float* MR = (LAS float*)lds;
    LAS bf16* IM = (LAS bf16*)(lds + 2048);
    const int t0 = n * 128, d0 = h * 256;
    const int fr = lane & 15, fq = lane >> 4;
    float st_s = 0.f, st_q = 0.f;
    if (tid < 128) { st_s = stats[2 * (t0 + tid)]; st_q = stats[2 * (t0 + tid) + 1]; }
    const int c8 = (tid & 31) * 8, j0 = tid >> 5;
    v4u rawv[8];
#pragma unroll
    for (int it = 0; it < 8; ++it) rawv[it] = __builtin_nontemporal_load((const v4u*)(V + (size_t)(t0 + j0 + 16 * it) * AW + d0 + c8));
    const f32x4 g0 = *(const f32x4*)(ln_g + d0 + c8), g1 = *(const f32x4*)(ln_g + d0 + c8 + 4), b0 = *(const f32x4*)(ln_b + d0 + c8), b1 = *(const f32x4*)(ln_b + d0 + c8 + 4);
    const bf16* wbase = Wsp + (size_t)h * 16384;
    bf16x8 wf[4][8];
#pragma unroll
    for (int ks = 0; ks < 4; ++ks)
#pragma unroll
        for (int ib = 0; ib < 8; ++ib) if (32 * ks <= 16 * ib + 15) wf[ks][ib] = *(const bf16x8*)(wbase + (16 * ib + fr) * 128 + 32 * ks + 8 * fq);
    asm volatile("" ::: "memory");
    if (tid < 128) { const float mu = st_s * (1.0f / AW), var = fmaxf(st_q * (1.0f / AW) - mu * mu, 0.f), rstd = 1.0f / sqrtf(var + EPS);
        MR[2 * tid] = rstd; MR[2 * tid + 1] = -mu * rstd; }
    __syncthreads();
#pragma unroll
    for (int it = 0; it < 8; ++it) { const int j = j0 + 16 * it; const float rs = MR[2 * j], cc = MR[2 * j + 1]; const v4u raw = rawv[it];
        const f32x4 va = (f32x4){bflo(raw.x), bfhi(raw.x), bflo(raw.y), bfhi(raw.y)}, vb = (f32x4){bflo(raw.z), bfhi(raw.z), bflo(raw.w), bfhi(raw.w)};
        const f32x4 oa = (va * rs + cc) * g0 + b0, ob = (vb * rs + cc) * g1 + b1;
        v4u pk; pk.x = pg8::cvt_pk_bf16(oa[0], oa[1]); pk.y = pg8::cvt_pk_bf16(oa[2], oa[3]); pk.z = pg8::cvt_pk_bf16(ob[0], ob[1]); pk.w = pg8::cvt_pk_bf16(ob[2], ob[3]);
        *(LAS v4u*)(IM + j * 264 + c8) = pk; }
    __syncthreads();
    f32x4 acc[2][8];
#pragma unroll
    for (int a = 0; a < 2; ++a)
#pragma unroll
        for (int b = 0; b < 8; ++b) acc[a][b] = (f32x4){0.f, 0.f, 0.f, 0.f};
    const LAS bf16* trb = IM + (8 * fq + (fr >> 2)) * 264 + 32 * wave + 4 * (fr & 3);
#pragma unroll
    for (int ks = 0; ks < 4; ++ks) {
        bf16x8 a[2];
#pragma unroll
        for (int dbi = 0; dbi < 2; ++dbi) {
            const v4s lo = __builtin_amdgcn_ds_read_tr16_b64_v4i16((LAS v4s*)(trb + (32 * ks) * 264 + 16 * dbi));
            const v4s hi = __builtin_amdgcn_ds_read_tr16_b64_v4i16((LAS v4s*)(trb + (32 * ks + 4) * 264 + 16 * dbi));
            a[dbi] = (bf16x8){lo[0], lo[1], lo[2], lo[3], hi[0], hi[1], hi[2], hi[3]}; }
#pragma unroll
        for (int ib = 0; ib < 8; ++ib) {
            if (32 * ks <= 16 * ib + 15) {
                const bf16x8 b = wf[ks][ib];
#pragma unroll
                for (int dbi = 0; dbi < 2; ++dbi) acc[dbi][ib] = __builtin_amdgcn_mfma_f32_16x16x32_bf16(a[dbi], b, acc[dbi][ib], 0, 0, 0);
            }
        }
    }
    v4u uu[8];
#pragma unroll
    for (int it = 0; it < 8; ++it) { const int idx = tid + 512 * it; uu[it] = __builtin_nontemporal_load((const v4u*)(U + (size_t)(t0 + (idx >> 5)) * AW + d0 + (idx & 31) * 8)); }
    __syncthreads();
    LAS bf16* OUT = IM;
#pragma unroll
    for (int ib = 0; ib < 8; ++ib) { const int i = 16 * ib + fr; const float bs = b_sp[h * 128 + i];
#pragma unroll
        for (int dbi = 0; dbi < 2; ++dbi) { const f32x4 m = acc[dbi][ib] + bs;
            v2u o; o.x = pg8::cvt_pk_bf16(m[0], m[1]); o.y = pg8::cvt_pk_bf16(m[2], m[3]);
            *(LAS v2u*)(OUT + i * 264 + 16 * (2 * wave + dbi) + 4 * fq) = o; } }
    __syncthreads();
#pragma unroll
    for (int it = 0; it < 8; ++it) { const int idx = tid + 512 * it, i = idx >> 5, cc8 = (idx & 31) * 8;
        const v4u mx = *(const LAS v4u*)(OUT + i * 264 + cc8); const v4u ux = uu[it];
        v4u o; o.x = pg8::cvt_pk_bf16(bflo(ux.x) * bflo(mx.x), bfhi(ux.x) * bfhi(mx.x)); o.y = pg8::cvt_pk_bf16(bflo(ux.y) * bflo(mx.y), bfhi(ux.y) * bfhi(mx.y));
        o.z = pg8::cvt_pk_bf16(bflo(ux.z) * bflo(mx.z), bfhi(ux.z) * bfhi(mx.z)); o.w = pg8::cvt_pk_bf16(bflo(ux.w) * bflo(mx.w), bfhi(ux.w) * bfhi(mx.w));
        *(v4u*)(SGPB + (size_t)(t0 + i) * KAB + d0 + cc8) = o; }
}
__device__ __forceinline__ void p3_pool(LAS unsigned char* lds, int r, int gi, const bf16* P, const bf16* WpT, const float* pscale, bf16* SGPB, int tid, int lane, int wave) {
    LAS bf16* Ap = (LAS bf16*)lds;
    const int t0 = r * 128, win = 2 << gi;
    const int fr = lane & 15, fq = lane >> 4;
    const bf16* wbase = WpT + (size_t)gi * 65536;
    bf16x8 af[8][2];
#pragma unroll
    for (int ks = 0; ks < 8; ++ks)
#pragma unroll
        for (int ebi = 0; ebi < 2; ++ebi) af[ks][ebi] = *(const bf16x8*)(wbase + (16 * (2 * wave + ebi) + fr) * 256 + 32 * ks + 8 * fq);
    {
        const int q8 = (tid & 31) * 8, tl0 = (tid >> 5) * 8; const bf16* pc = P + gi * 256 + q8;
        float sum[8] = {0.f, 0.f, 0.f, 0.f, 0.f, 0.f, 0.f, 0.f};
#pragma unroll
        for (int sI = 1; sI < 16; ++sI) { const int ts = t0 + tl0 - sI; const float fct = (sI < win && ts >= 0) ? 1.f : 0.f;
            const v4u raw = *(const v4u*)(pc + (size_t)(ts >= 0 ? ts : 0) * BW);
            sum[0] += fct * bflo(raw.x); sum[1] += fct * bfhi(raw.x); sum[2] += fct * bflo(raw.y); sum[3] += fct * bfhi(raw.y); sum[4] += fct * bflo(raw.z); sum[5] += fct * bfhi(raw.z); sum[6] += fct * bflo(raw.w); sum[7] += fct * bfhi(raw.w); }
#pragma unroll
        for (int k = 0; k < 8; ++k) { const int t = t0 + tl0 + k; const v4u raw = *(const v4u*)(pc + (size_t)t * BW);
            const float self[8] = {bflo(raw.x), bfhi(raw.x), bflo(raw.y), bfhi(raw.y), bflo(raw.z), bfhi(raw.z), bflo(raw.w), bfhi(raw.w)};
#pragma unroll
            for (int e = 0; e < 8; ++e) sum[e] += self[e];
            const int cnt = (t + 1 < win) ? (t + 1) : win; const float inv = 1.0f / (float)cnt;
            v4u o; o.x = pg8::cvt_pk_bf16(sum[0] * inv - self[0], sum[1] * inv - self[1]); o.y = pg8::cvt_pk_bf16(sum[2] * inv - self[2], sum[3] * inv - self[3]);
            o.z = pg8::cvt_pk_bf16(sum[4] * inv - self[4], sum[5] * inv - self[5]); o.w = pg8::cvt_pk_bf16(sum[6] * inv - self[6], sum[7] * inv - self[7]);
            *(LAS v4u*)(Ap + (tl0 + k) * 264 + q8) = o;
            const int td = t - win + 1;
            { const float fct = (td >= 0) ? 1.f : 0.f; const v4u rd = *(const v4u*)(pc + (size_t)(td >= 0 ? td : 0) * BW);
                sum[0] -= fct * bflo(rd.x); sum[1] -= fct * bfhi(rd.x); sum[2] -= fct * bflo(rd.y); sum[3] -= fct * bfhi(rd.y); sum[4] -= fct * bflo(rd.z); sum[5] -= fct * bfhi(rd.z); sum[6] -= fct * bflo(rd.w); sum[7] -= fct * bfhi(rd.w); } }
    }
    __syncthreads();
    f32x4 acc[2][8];
#pragma unroll
    for (int a = 0; a < 2; ++a)
#pragma unroll
        for (int b = 0; b < 8; ++b) acc[a][b] = (f32x4){0.f, 0.f, 0.f, 0.f};
#pragma unroll
    for (int ks = 0; ks < 8; ++ks) {
        bf16x8 a[2];
#pragma unroll
        for (int ebi = 0; ebi < 2; ++ebi) a[ebi] = af[ks][ebi];
#pragma unroll
        for (int tb = 0; tb < 8; ++tb) { const bf16x8 b = *(const LAS bf16x8*)(Ap + (16 * tb + fr) * 264 + 32 * ks + 8 * fq);
#pragma unroll
            for (int ebi = 0; ebi < 2; ++ebi) acc[ebi][tb] = __builtin_amdgcn_mfma_f32_16x16x32_bf16(a[ebi], b, acc[ebi][tb], 0, 0, 0); }
    }
    __syncthreads();
#pragma unroll
    for (int ebi = 0; ebi < 2; ++ebi) { const int e = 16 * (2 * wave + ebi) + 4 * fq; const f32x4 sc = *(const f32x4*)(pscale + gi * 256 + e);
#pragma unroll
        for (int tb = 0; tb < 8; ++tb) { const f32x4 m = acc[ebi][tb] * sc;
            v2u o; o.x = pg8::cvt_pk_bf16(m[0], m[1]); o.y = pg8::cvt_pk_bf16(m[2], m[3]);
            *(LAS v2u*)(Ap + (16 * tb + fr) * 264 + e) = o; } }
    __syncthreads();
#pragma unroll
    for (int it = 0; it < 8; ++it) { const int idx = tid + 512 * it, t = idx >> 5, c8 = (idx & 31) * 8;
        *(v4u*)(SGPB + (size_t)(t0 + t) * KAB + AW + gi * 256 + c8) = *(const LAS v4u*)(Ap + t * 264 + c8); }
}

struct Params { const float* in[22]; float* out; unsigned char* ws; int ph_lo, ph_hi; };
enum { I_X = 0, I_C, I_WADA, I_BADA, I_GPREMIX, I_GPOSTMIX, I_WIN, I_LNG, I_LNB, I_WSP, I_BSP, I_WPOOL, I_PSCALE, I_WA, I_WB, I_WOUT, I_GPREFFN, I_GPOSTFFN, I_WUP, I_CONVW, I_CONVB, I_WDN };

__global__ void __launch_bounds__(NWAVES * 64, 2) fwd_megakernel(Params p) {
    extern __shared__ __attribute__((aligned(16))) unsigned char lds_raw[];
    LAS unsigned char* lds = (LAS unsigned char*)lds_raw;
    volatile LAS unsigned* MISC = (volatile LAS unsigned*)(lds + MISC_OFF);
    const int tid = threadIdx.x, lane = tid & 63, wave = __builtin_amdgcn_readfirstlane(tid >> 6);
    const int G = gridDim.x, bx = blockIdx.x, vcu = (G % 8 == 0) ? (bx % 8) * (G / 8) + bx / 8 : bx;
    const int gw = vcu * NWAVES + wave, NGW = G * NWAVES;
    unsigned char* ws = p.ws;
    for (int u = tid; u < (LDS_BYTES - LDSCTL_OFF) / 4; u += NWAVES * 64) ((LAS unsigned*)(lds + LDSCTL_OFF))[u] = 0u;
    __syncthreads();
    const int lo = p.ph_lo, hi = p.ph_hi;
    XcdBarrier bar; bar.bar = (unsigned*)(ws + WS_CTL) + CW_BAR; bar.x = 0; bar.st = nullptr;
    if (hi - lo > 1) bar = xcd_barrier_post((unsigned*)(ws + WS_CTL) + CW_BAR, MISC + 8);
#define IN(k) (lo <= (k) && (k) < hi)
#define SEAM(k) do { if (IN(k) && IN((k) + 1)) xcd_barrier(bar); } while (0)

    float* MOD = (float*)(ws + WS_MOD); float* STATS = (float*)(ws + WS_STATS); float* VEC = (float*)(ws + WS_VEC);
    bf16 *Win_t = (bf16*)(ws + WS_WIN), *Wab_t = (bf16*)(ws + WS_WAB), *Wout_t = (bf16*)(ws + WS_WOUT), *Wup_t = (bf16*)(ws + WS_WUP), *Wdn_t = (bf16*)(ws + WS_WDN), *WpT = (bf16*)(ws + WS_WPOOL), *Wsp = (bf16*)(ws + WS_WSP);
    bf16 *H1 = (bf16*)(ws + WS_H1), *Ub = (bf16*)(ws + WS_U), *Vb = (bf16*)(ws + WS_V), *Pb = (bf16*)(ws + WS_P), *GA = (bf16*)(ws + WS_GA), *GB = (bf16*)(ws + WS_GB);
    bf16 *SGPB = (bf16*)(ws + WS_SGPB), *MERGED = (bf16*)(ws + WS_MERGED), *ACT = (bf16*)(ws + WS_ACT), *H2 = (bf16*)(ws + WS_H2);
    float *MIX = (float*)(ws + WS_MIX), *Y = (float*)(ws + WS_Y), *RAWB = (float*)(ws + WS_RAWB);
    const float* x = p.in[I_X]; float* out = p.out;

    unsigned* const gcnt = (unsigned*)(ws + WS_CTL) + 16;
    const bool split = false;
    const bool gemv_role = !split || (((bx >> 3) & 1) == 0);
    const int n_gemv = split ? G / 2 : G, i_gemv = split ? (bx >> 4) * 8 + (bx & 7) : vcu, n_conv = split ? G / 2 : G, i_conv = split ? (bx >> 4) * 8 + (bx & 7) : vcu;
    if (IN(0)) {
        if (gemv_role) {
            p0_mod_gemv(p.in[I_C], p.in[I_WADA], p.in[I_BADA], MOD, lds + RING_OFF, i_gemv, n_gemv, tid, lane, wave);
            VM_WAIT(); __syncthreads();
            if (tid == 0) __hip_atomic_fetch_add(gcnt, 1u, RLX_AGENT);
        }
        if (!split || !gemv_role) { LAS float* scr = (LAS float*)(lds + RING_OFF + wave * 16384);
            const ListP0 L{p.in[I_WIN], p.in[I_WPOOL], Win_t, WpT}; convert_list(L, ListP0::NITEMS, i_conv * NWAVES + wave, n_conv * NWAVES, scr, lane); }
        for (int idx = gw * 64 + lane; idx < 8 * 128 * 128; idx += NGW * 64) { const int i = (idx >> 7) & 127, j = idx & 127; Wsp[idx] = (bf16)((j <= i) ? f2bf(p.in[I_WSP][idx]) : 0u); }
    }
    if (IN(0) && IN(1)) {
        if (wave == 0) { unsigned sp = 0;
            while ((unsigned)__builtin_amdgcn_readfirstlane(__hip_atomic_load(gcnt, RLX_AGENT)) < (unsigned)n_gemv) { __builtin_amdgcn_s_sleep(2); if (++sp > (1u << 20)) break; }
            __builtin_amdgcn_fence(__ATOMIC_ACQUIRE, "agent"); VM_WAIT(); }
        __syncthreads();
    }
    if (IN(1)) {
        if (bx == 0) for (int cc = tid; cc < DM; cc += NWAVES * 64) {
            VEC[cc] = MOD[2 * DM + cc] * p.in[I_GPOSTMIX][cc];
            VEC[DM + cc] = p.in[I_GPREFFN][cc] * (1.0f + MOD[4 * DM + cc]);
            VEC[2 * DM + cc] = MOD[3 * DM + cc];
            VEC[3 * DM + cc] = MOD[5 * DM + cc] * p.in[I_GPOSTFFN][cc]; }
        f32x4 ca[8], cb[8];
#pragma unroll
        for (int j = 0; j < 8; ++j) { const int cc = 8 * lane + 512 * (j >> 1) + 4 * (j & 1); const f32x4 g = *(const f32x4*)(p.in[I_GPREMIX] + cc), sc = *(const f32x4*)(MOD + DM + cc); ca[j] = g * (sc + 1.0f); cb[j] = *(const f32x4*)(MOD + cc); }
        {   int m = gw; f32x4 v[8], nx[8];
            if (m < SEQ) { const f32x4* xr = (const f32x4*)(x + (size_t)m * DM) + 2 * lane;
#pragma unroll
                for (int j = 0; j < 8; ++j) v[j] = __builtin_nontemporal_load(xr + 128 * (j >> 1) + (j & 1)); }
            for (; m < SEQ; m += NGW) {
                const int mn = (m + NGW < SEQ) ? m + NGW : m;
                { const f32x4* xr = (const f32x4*)(x + (size_t)mn * DM) + 2 * lane;
#pragma unroll
                  for (int j = 0; j < 8; ++j) nx[j] = __builtin_nontemporal_load(xr + 128 * (j >> 1) + (j & 1)); }
                asm volatile("" ::: "memory");
                float ss = 0.f;
#pragma unroll
                for (int j = 0; j < 8; ++j) ss += (v[j][0] * v[j][0] + v[j][1] * v[j][1]) + (v[j][2] * v[j][2] + v[j][3] * v[j][3]);
                const float rstd = 1.0f / sqrtf(wave_sum(ss) * (1.0f / DM) + EPS);
                v4u* o16 = (v4u*)(H1 + (size_t)m * DM) + lane;
#pragma unroll
                for (int jq = 0; jq < 4; ++jq) { const f32x4 ha = v[2 * jq] * rstd * ca[2 * jq] + cb[2 * jq], hb = v[2 * jq + 1] * rstd * ca[2 * jq + 1] + cb[2 * jq + 1];
                    v4u o; o.x = pg8::cvt_pk_bf16(ha[0], ha[1]); o.y = pg8::cvt_pk_bf16(ha[2], ha[3]); o.z = pg8::cvt_pk_bf16(hb[0], hb[1]); o.w = pg8::cvt_pk_bf16(hb[2], hb[3]); o16[64 * jq] = o; }
#pragma unroll
                for (int j = 0; j < 8; ++j) v[j] = nx[j];
            }
        }
    }
    SEAM(1);
    if (IN(2)) {
        pg8::Gemm g{H1, Win_t, SEQ, INC, DM}; pg8::StaticOrder S; S.init(SEQ, INC, G, bx);
        pg8::EpiIn E{Ub, Vb, Pb, GA, GB, STATS};
        pg8::gemm_phase<pg8::EpiIn, pg8::StaticOrder, true, true, 16>(lds + RING_OFF, g, S, E);
        {
            const int rem = (32 * 36) % G, nidle = rem ? G - rem : G, idle = rem ? bx - rem : bx;
            if (idle >= 0) { LAS float* scr = (LAS float*)(lds + RING_OFF + wave * 16384);
                const ListP2 L{p.in[I_WA], p.in[I_WB], p.in[I_WOUT], p.in[I_WUP], Wab_t, Wout_t, Wup_t}; convert_list(L, ListP2::NITEMS, idle * NWAVES + wave, nidle * NWAVES, scr, lane); }
        }
    }
    SEAM(2);
    if (IN(3)) {
        for (int u = vcu; u < 768; u += G) {
            __syncthreads();
            if (u < 512) p3_spatial(lds + RING_OFF, u >> 3, u & 7, Vb, Ub, STATS, p.in[I_LNG], p.in[I_LNB], Wsp, p.in[I_BSP], SGPB, tid, lane, wave);
            else p3_pool(lds + RING_OFF, (u - 512) >> 2, (u - 512) & 3, Pb, WpT, p.in[I_PSCALE], SGPB, tid, lane, wave);
        }
        __syncthreads();
    }
    SEAM(3);
    if (IN(4)) {
        pg8::Gemm g{SGPB, Wab_t, SEQ, DM, KAB}; pg8::StaticOrder S; S.init(SEQ, DM, G, bx);
        pg8::EpiMerge E{GA, GB, MERGED};
        pg8::gemm_phase<pg8::EpiMerge, pg8::StaticOrder, true, true>(lds + RING_OFF, g, S, E);
    }
    SEAM(4);
    const bool fuse = (G == 256);
    unsigned* const xb = (unsigned*)(ws + WS_XBUF); unsigned* const pc = (unsigned*)(ws + WS_CNT); unsigned* const tmo = (unsigned*)(ws + WS_CTL) + 2;
    if (IN(5)) {
        pg8::Gemm g{MERGED, Wout_t, SEQ, DM, DM}; pg8::StaticOrder S; S.init(SEQ, DM, G, bx);
        if (fuse) {
            pg8::EpiMixFused E{x, (bf16*)(ws + WS_Y), H2, VEC, pg8::PanelSS{xb, pc, tmo, EPS}, pg8::PanelSS{xb + 65536, pc + 2048, tmo, EPS}};
            pg8::gemm_phase<pg8::EpiMixFused, pg8::StaticOrder, false, true>(lds + RING_OFF, g, S, E);
        } else {
            pg8::EpiF32 E{MIX, DM};
            pg8::gemm_phase<pg8::EpiF32, pg8::StaticOrder, true, true>(lds + RING_OFF, g, S, E);
        }
    }
    if (!fuse) SEAM(5);
    if (IN(6) && !fuse) {
        {   int m = gw; f32x4 v[8], w[8], nv[8], nw[8];
            if (m < SEQ) { const f32x4* xr = (const f32x4*)(x + (size_t)m * DM) + lane; const f32x4* mr = (const f32x4*)(MIX + (size_t)m * DM) + lane;
#pragma unroll
                for (int j = 0; j < 8; ++j) { v[j] = xr[64 * j]; w[j] = mr[64 * j]; } }
            for (; m < SEQ; m += NGW) {
                const int mn = (m + NGW < SEQ) ? m + NGW : m;
                { const f32x4* xr = (const f32x4*)(x + (size_t)mn * DM) + lane; const f32x4* mr = (const f32x4*)(MIX + (size_t)mn * DM) + lane;
#pragma unroll
                  for (int j = 0; j < 8; ++j) { nv[j] = xr[64 * j]; nw[j] = mr[64 * j]; } }
                asm volatile("" ::: "memory");
                float ss = 0.f;
#pragma unroll
                for (int j = 0; j < 8; ++j) ss += (w[j][0] * w[j][0] + w[j][1] * w[j][1]) + (w[j][2] * w[j][2] + w[j][3] * w[j][3]);
                const float rstd = 1.0f / sqrtf(wave_sum(ss) * (1.0f / DM) + EPS); float s1 = 0.f;
                f32x4* o4 = (f32x4*)(out + (size_t)m * DM) + lane;
#pragma unroll
                for (int j = 0; j < 8; ++j) { const f32x4 g1 = *((const f32x4*)VEC + lane + 64 * j); v[j] = v[j] + g1 * (w[j] * rstd); o4[64 * j] = v[j];
                    s1 += (v[j][0] * v[j][0] + v[j][1] * v[j][1]) + (v[j][2] * v[j][2] + v[j][3] * v[j][3]); }
                const float rstd1 = 1.0f / sqrtf(wave_sum(s1) * (1.0f / DM) + EPS);
                uint2* o8 = (uint2*)(H2 + (size_t)m * DM) + lane;
#pragma unroll
                for (int j = 0; j < 8; ++j) { const f32x4 a2 = *((const f32x4*)(VEC + DM) + lane + 64 * j), b2 = *((const f32x4*)(VEC + 2 * DM) + lane + 64 * j);
                    const f32x4 h = v[j] * rstd1 * a2 + b2; uint2 o; o.x = pk2(h[0], h[1]); o.y = pk2(h[2], h[3]); o8[64 * j] = o; }
#pragma unroll
                for (int j = 0; j < 8; ++j) { v[j] = nv[j]; w[j] = nw[j]; }
            }
        }
    }
    SEAM(6);
    if (IN(7)) {
        pg8::Gemm g{H2, Wup_t, SEQ, FF2, DM, (size_t)FF * DM * 2, (size_t)128 * DM * 2}; pg8::StaticOrder S; S.init(SEQ, FF2, G, bx);
        pg8::EpiUpConv E{ACT, RAWB, p.in[I_CONVW], p.in[I_CONVB], lds + XCH_OFF};
        pg8::gemm_phase<pg8::EpiUpConv, pg8::StaticOrder, true, true, 0>(lds + RING_OFF, g, S, E);
        {
            const int rem = (32 * 44) % G, nidle = rem ? G - rem : G, idle = rem ? bx - rem : bx;
            if (idle >= 0) { LAS float* scr = (LAS float*)(lds + RING_OFF + wave * 16384);
                const ListOne L{p.in[I_WDN], Wdn_t, DM, FF, 0, 0}; convert_list(L, (FF / 64) * (DM / 32), idle * NWAVES + wave, nidle * NWAVES, scr, lane); }
        }
    }
    SEAM(7);
    if (IN(8)) {
        pg8::Gemm g{ACT, Wdn_t, SEQ, DM, FF}; pg8::FixOrder S; S.init(SEQ, DM, G, bx); S.ACT = ACT; S.RAWB = RAWB; S.cw = p.in[I_CONVW]; S.cb = p.in[I_CONVB];
        if (fuse) {
            pg8::EpiOutFused E{(const bf16*)(ws + WS_Y), out, VEC, pg8::PanelSS{xb + 2 * 65536, pc + 2 * 2048, tmo, EPS}};
            pg8::gemm_phase<pg8::EpiOutFused, pg8::FixOrder, false, true>(lds + RING_OFF, g, S, E);
        } else {
            pg8::EpiF32 E{Y, DM};
            pg8::gemm_phase<pg8::EpiF32, pg8::FixOrder, true, true>(lds + RING_OFF, g, S, E);
        }
    }
    if (!fuse) SEAM(8);
    if (IN(9) && !fuse) {
        {   int m = gw; f32x4 v[8], w[8], nv[8], nw[8];
            if (m < SEQ) { const f32x4* xr = (const f32x4*)(out + (size_t)m * DM) + lane; const f32x4* yr = (const f32x4*)(Y + (size_t)m * DM) + lane;
#pragma unroll
                for (int j = 0; j < 8; ++j) { v[j] = xr[64 * j]; w[j] = yr[64 * j]; } }
            for (; m < SEQ; m += NGW) {
                const bool has = (m + NGW < SEQ); const int mn = has ? m + NGW : m;
                if (has) { const f32x4* xr = (const f32x4*)(out + (size_t)mn * DM) + lane; const f32x4* yr = (const f32x4*)(Y + (size_t)mn * DM) + lane;
#pragma unroll
                  for (int j = 0; j < 8; ++j) { nv[j] = xr[64 * j]; nw[j] = yr[64 * j]; } }
                asm volatile("" ::: "memory");
                float ss = 0.f;
#pragma unroll
                for (int j = 0; j < 8; ++j) ss += (w[j][0] * w[j][0] + w[j][1] * w[j][1]) + (w[j][2] * w[j][2] + w[j][3] * w[j][3]);
                const float rstd = 1.0f / sqrtf(wave_sum(ss) * (1.0f / DM) + EPS);
                f32x4* o4 = (f32x4*)(out + (size_t)m * DM) + lane;
#pragma unroll
                for (int j = 0; j < 8; ++j) { const f32x4 g2 = *((const f32x4*)(VEC + 3 * DM) + lane + 64 * j); o4[64 * j] = v[j] + g2 * (w[j] * rstd); }
                if (has) {
#pragma unroll
                    for (int j = 0; j < 8; ++j) { v[j] = nv[j]; w[j] = nw[j]; } }
            }
        }
    }
#undef IN
#undef SEAM
}

extern "C" void kernel_launch(void* const* d_in, const int* in_sizes, int n_in, void* d_out, int out_size, void* d_ws, size_t ws_size, hipStream_t stream) {
    static int grid = 0;
    if (grid == 0) {
        if (n_in != 22 || in_sizes[0] != SEQ * DM || out_size != SEQ * DM || ws_size < WS_END) { fprintf(stderr, "kernel_launch: unexpected shapes (n_in %d, in0 %d, out %d, ws %zu < %zu)\n", n_in, n_in > 0 ? in_sizes[0] : -1, out_size, ws_size, (size_t)WS_END); grid = -1; return; }
        int dev = 0, cus = 0, per_cu = 0;
        if (hipGetDevice(&dev) != hipSuccess || hipDeviceGetAttribute(&cus, hipDeviceAttributeMultiprocessorCount, dev) != hipSuccess) { grid = -1; return; }
        if (hipFuncSetAttribute((const void*)fwd_megakernel, hipFuncAttributeMaxDynamicSharedMemorySize, LDS_BYTES) != hipSuccess) { fprintf(stderr, "kernel_launch: hipFuncSetAttribute failed\n"); grid = -1; return; }
        if (hipOccupancyMaxActiveBlocksPerMultiprocessor(&per_cu, (const void*)fwd_megakernel, NWAVES * 64, LDS_BYTES) != hipSuccess || per_cu < 1) { fprintf(stderr, "kernel_launch: occupancy query says %d blocks per CU\n", per_cu); grid = -1; (void)hipGetLastError(); return; }
        grid = cus;
    }
    if (grid < 0) return;
    (void)hipMemsetAsync((char*)d_ws + WS_CTL, 0, CTL_ZERO_BYTES, stream);
    Params a{};
    for (int i = 0; i < 22; ++i) a.in[i] = (const float*)d_in[i];
    a.out = (float*)d_out; a.ws = (unsigned char*)d_ws;
#if defined(PROBE_DUP)
    a.ph_lo = 0; a.ph_hi = PROBE_DUP + 1;
    hipLaunchKernelGGL(fwd_megakernel, dim3(grid), dim3(NWAVES * 64), LDS_BYTES, stream, a);
    (void)hipMemsetAsync((char*)d_ws + WS_CTL, 0, WS_MOD, stream);
    if (PROBE_DUP == 0) (void)hipMemsetAsync((char*)d_ws + WS_MOD, 0, NMOD * 4, stream);
    if (PROBE_DUP <= 2) (void)hipMemsetAsync((char*)d_ws + WS_STATS, 0, SEQ * 8, stream);
    a.ph_lo = PROBE_DUP; a.ph_hi = NPHASES;
    hipLaunchKernelGGL(fwd_megakernel, dim3(grid), dim3(NWAVES * 64), LDS_BYTES, stream, a);
#else
    for (int li = 0; li < N_LAUNCHES; ++li) {
        a.ph_lo = (N_LAUNCHES == 1) ? 0 : li; a.ph_hi = (N_LAUNCHES == 1) ? NPHASES : li + 1;
        hipLaunchKernelGGL(fwd_megakernel, dim3(grid), dim3(NWAVES * 64), LDS_BYTES, stream, a);
    }
#endif
}
```

```cpp
#include <hip/hip_runtime.h>
#include <cstdio>
#include <cstdint>
namespace pg8 {
#define PG8_LAS __attribute__((address_space(3)))
typedef unsigned short bf16_t;
typedef short bf16x8 __attribute__((ext_vector_type(8)));
typedef float f32x4 __attribute__((ext_vector_type(4)));
typedef unsigned u32x4 __attribute__((ext_vector_type(4)));
constexpr int BM = 256, BK = 64, HALF = 128, HTB = HALF * BK * 2  , STAGE_BYTES = 8 * HTB, NXCD = 8, WGM = 8;

__host__ __device__ __forceinline__ int lds_byte(int r, int c) { const int st = (r >> 4) * 2 + (c >> 5), rr = r & 15, cc = c & 31, ob = rr * 64 + cc * 2; return st * 1024 + (ob ^ (((ob >> 9) & 1) << 5)); }
__host__ __device__ __forceinline__ void stage_rc(int b, int& R, int& C) { const int st = b / 1024, sb = b % 1024, swz = sb ^ (((sb >> 9) & 1) << 5); R = (st >> 1) * 16 + swz / 64; C = (st & 1) * 32 + (swz % 64) / 2; }
__host__ __device__ __forceinline__ int perm32(int rho) { const int n = rho >> 4, i = rho & 15; return 8 * (i >> 2) + 4 * n + (i & 3); }

struct Unit { int pm, pn; };
struct Gemm { const bf16_t* A; const bf16_t* Bt; int M, N, K; size_t b_hstep, b_tstep; };

struct StaticOrder {
    int nM, nN, nwg, G, c;
    __host__ __device__ void init(int M, int N, int G_, int c_) { nM = M / BM; nN = N / BM; nwg = nM * nN; G = G_; c = c_; }
    __host__ __device__ bool next(int i, Unit& u) const {
        const long L = (long)i * G + c; if (L >= nwg) return false;
        int wgid = (int)L; { const int q = nwg / NXCD, r = nwg % NXCD, xcd = wgid % NXCD, off = wgid / NXCD; wgid = (xcd < r ? xcd * (q + 1) : r * (q + 1) + (xcd - r) * q) + off; }
        const int nig = WGM * nN, gid = wgid / nig, fm = gid * WGM, gsz = (nM - fm) < WGM ? (nM - fm) : WGM;
        u.pm = fm + ((wgid % nig) % gsz); u.pn = (wgid % nig) / gsz; return true;
    }
    __device__ __forceinline__ void a_ready(const Unit&) const {}
    __device__ __forceinline__ void done(const Unit&) const {}
};

__device__ __forceinline__ unsigned cvt_pk_bf16(float lo, float hi) { unsigned r; asm volatile("v_cvt_pk_bf16_f32 %0, %1, %2" : "=v"(r) : "v"(lo), "v"(hi)); return r; }
__device__ __forceinline__ float bf_lo(unsigned w) { return __builtin_bit_cast(float, w << 16); }
__device__ __forceinline__ float bf_hi(unsigned w) { return __builtin_bit_cast(float, w & 0xffff0000u); }
__device__ __forceinline__ float sigmoid_f(float z) { return __builtin_amdgcn_rcpf(1.0f + __builtin_amdgcn_exp2f(z * -1.44269504089f)); }
__device__ __forceinline__ float gelu_tanh_f(float x) { const float z = x * (1.5957691216f + 0.0713548163f * x * x); return x * sigmoid_f(z); }

typedef float f32x2 __attribute__((ext_vector_type(2)));
__device__ __forceinline__ f32x2 gelu_pk(f32x2 x) { const f32x2 t = (x * x) * (-0.102943264f) + (-2.302208198f); const f32x2 z = x * t;
    f32x2 e; e.x = __builtin_amdgcn_exp2f(z.x); e.y = __builtin_amdgcn_exp2f(z.y); e = e + 1.0f; f32x2 r; r.x = __builtin_amdgcn_rcpf(e.x); r.y = __builtin_amdgcn_rcpf(e.y); return x * r; }
__device__ __forceinline__ f32x2 sigmoid_pk(f32x2 x) { const f32x2 z = x * (-1.44269504089f);
    f32x2 e; e.x = __builtin_amdgcn_exp2f(z.x); e.y = __builtin_amdgcn_exp2f(z.y); e = e + 1.0f; f32x2 r; r.x = __builtin_amdgcn_rcpf(e.x); r.y = __builtin_amdgcn_rcpf(e.y); return r; }
__device__ __forceinline__ f32x4 gelu_v4(f32x4 v) { const f32x2 a = gelu_pk((f32x2){v[0], v[1]}), b = gelu_pk((f32x2){v[2], v[3]}); return (f32x4){a.x, a.y, b.x, b.y}; }
__device__ __forceinline__ f32x4 sigmoid_v4(f32x4 v) { const f32x2 a = sigmoid_pk((f32x2){v[0], v[1]}), b = sigmoid_pk((f32x2){v[2], v[3]}); return (f32x4){a.x, a.y, b.x, b.y}; }

struct EpiIn {
    static constexpr bool PERMA = false, PERM = true, AFTER_DRAIN = false; static constexpr int MIDK = 0;
    bf16_t *U, *V, *P, *GA, *GB; float* stats;
    __device__ __forceinline__ void mid(f32x4 (&)[2][2][4][2], const Unit&, int, int, int, int) const {}
    __device__ __forceinline__ void operator()(const f32x4 (&acc)[2][2][4][2], const Unit& u, int wr, int wc, int fr, int fq) const {
        const int pn = u.pn; bf16_t* base; int ldc, colt, act;
        if (pn < 8) { base = U; ldc = 2048; colt = pn * BM; act = 1; }
        else if (pn < 16) { base = V; ldc = 2048; colt = (pn - 8) * BM; act = 3; }
        else if (pn < 20) { base = P; ldc = 1024; colt = (pn - 16) * BM; act = 0; }
        else if (pn < 28) { base = GA; ldc = 2048; colt = (pn - 20) * BM; act = 2; }
        else { base = GB; ldc = 2048; colt = (pn - 28) * BM; act = 2; }
        const int row0 = u.pm * BM + wr * 64 + fr, col0 = colt + wc * 32 + 8 * fq;
#pragma unroll
        for (int ai = 0; ai < 2; ++ai)
#pragma unroll
            for (int m = 0; m < 4; ++m) { const int row = row0 + ai * HALF + m * 16; bf16_t* rowp = base + (size_t)row * ldc + col0; float s = 0.f, q = 0.f;
#pragma unroll
                for (int bj = 0; bj < 2; ++bj) { f32x4 v0 = acc[ai][bj][m][0], v1 = acc[ai][bj][m][1];
                    if (act == 1 || act == 3) { v0 = gelu_v4(v0); v1 = gelu_v4(v1); }
                    else if (act == 2) { v0 = sigmoid_v4(v0); v1 = sigmoid_v4(v1); }
                    if (act == 3) {
#pragma unroll
                        for (int j = 0; j < 4; ++j) { s += v0[j] + v1[j]; q += v0[j] * v0[j] + v1[j] * v1[j]; } }
                    u32x4 w; w.x = cvt_pk_bf16(v0[0], v0[1]); w.y = cvt_pk_bf16(v0[2], v0[3]); w.z = cvt_pk_bf16(v1[0], v1[1]); w.w = cvt_pk_bf16(v1[2], v1[3]);
                    *(u32x4*)(rowp + bj * HALF) = w; }
                if (act == 3) { s += __shfl_xor(s, 16); s += __shfl_xor(s, 32); q += __shfl_xor(q, 16); q += __shfl_xor(q, 32);
                    if (fq == 0) { atomicAdd(stats + 2 * row, s); atomicAdd(stats + 2 * row + 1, q); } } }
    }
};
struct EpiBf16Plain {
    static constexpr bool PERMA = false, PERM = true, AFTER_DRAIN = false; static constexpr int MIDK = 0;
    bf16_t* O; int ldc;
    __device__ __forceinline__ void mid(f32x4 (&)[2][2][4][2], const Unit&, int, int, int, int) const {}
    __device__ __forceinline__ void operator()(const f32x4 (&acc)[2][2][4][2], const Unit& u, int wr, int wc, int fr, int fq) const {
        const int row0 = u.pm * BM + wr * 64 + fr, col0 = u.pn * BM + wc * 32 + 8 * fq;
#pragma unroll
        for (int ai = 0; ai < 2; ++ai)
#pragma unroll
            for (int m = 0; m < 4; ++m) { bf16_t* rowp = O + (size_t)(row0 + ai * HALF + m * 16) * ldc + col0;
#pragma unroll
                for (int bj = 0; bj < 2; ++bj) { const f32x4 v0 = acc[ai][bj][m][0], v1 = acc[ai][bj][m][1];
                    u32x4 w; w.x = cvt_pk_bf16(v0[0], v0[1]); w.y = cvt_pk_bf16(v0[2], v0[3]); w.z = cvt_pk_bf16(v1[0], v1[1]); w.w = cvt_pk_bf16(v1[2], v1[3]);
                    *(u32x4*)(rowp + bj * HALF) = w; } }
    }
};
struct EpiMerge {
    static constexpr bool PERMA = false, PERM = true, AFTER_DRAIN = false; static constexpr int MIDK = 32;
    const bf16_t *GA, *GB; bf16_t* O;
    __device__ __forceinline__ void mid(f32x4 (&acc)[2][2][4][2], const Unit& u, int wr, int wc, int fr, int fq) const {
        int row0 = u.pm * BM + wr * 64 + fr; const int col0 = u.pn * BM + wc * 32 + 8 * fq;
        asm volatile("" : "+v"(row0));
#pragma unroll
        for (int ai = 0; ai < 2; ++ai)
#pragma unroll
            for (int m = 0; m < 4; ++m) { const size_t off = (size_t)(row0 + ai * HALF + m * 16) * 2048 + col0;
#pragma unroll
                for (int bj = 0; bj < 2; ++bj) { const u32x4 a = *(const u32x4*)(GA + off + bj * HALF), b = *(const u32x4*)(GB + off + bj * HALF);
                    f32x4 r0, r1;
                    r0[0] = bf_lo(a.x) * __builtin_amdgcn_rcpf(bf_lo(b.x)); r0[1] = bf_hi(a.x) * __builtin_amdgcn_rcpf(bf_hi(b.x));
                    r0[2] = bf_lo(a.y) * __builtin_amdgcn_rcpf(bf_lo(b.y)); r0[3] = bf_hi(a.y) * __builtin_amdgcn_rcpf(bf_hi(b.y));
                    r1[0] = bf_lo(a.z) * __builtin_amdgcn_rcpf(bf_lo(b.z)); r1[1] = bf_hi(a.z) * __builtin_amdgcn_rcpf(bf_hi(b.z));
                    r1[2] = bf_lo(a.w) * __builtin_amdgcn_rcpf(bf_lo(b.w)); r1[3] = bf_hi(a.w) * __builtin_amdgcn_rcpf(bf_hi(b.w));
                    acc[ai][bj][m][0] *= r0; acc[ai][bj][m][1] *= r1; }
                asm volatile("" ::: "memory"); }
    }
    __device__ __forceinline__ void operator()(const f32x4 (&acc)[2][2][4][2], const Unit& u, int wr, int wc, int fr, int fq) const {
        int row0 = u.pm * BM + wr * 64 + fr; const int col0 = u.pn * BM + wc * 32 + 8 * fq;
        asm volatile("" : "+v"(row0));
#pragma unroll
        for (int ai = 0; ai < 2; ++ai)
#pragma unroll
            for (int m = 0; m < 4; ++m) { const size_t off = (size_t)(row0 + ai * HALF + m * 16) * 2048 + col0;
#pragma unroll
                for (int bj = 0; bj < 2; ++bj) { const u32x4 b = *(const u32x4*)(GB + off + bj * HALF); const f32x4 v0 = acc[ai][bj][m][0], v1 = acc[ai][bj][m][1];
                    u32x4 w; w.x = cvt_pk_bf16(v0[0] * bf_lo(b.x), v0[1] * bf_hi(b.x)); w.y = cvt_pk_bf16(v0[2] * bf_lo(b.y), v0[3] * bf_hi(b.y));
                    w.z = cvt_pk_bf16(v1[0] * bf_lo(b.z), v1[1] * bf_hi(b.z)); w.w = cvt_pk_bf16(v1[2] * bf_lo(b.w), v1[3] * bf_hi(b.w));
                    *(u32x4*)(O + off + bj * HALF) = w; }
                asm volatile("" ::: "memory"); }
    }
};
struct EpiF32 {
    static constexpr bool PERMA = false, PERM = false, AFTER_DRAIN = false; static constexpr int MIDK = 0;
    float* C; int ldc;
    __device__ __forceinline__ void mid(f32x4 (&)[2][2][4][2], const Unit&, int, int, int, int) const {}
    __device__ __forceinline__ void operator()(const f32x4 (&acc)[2][2][4][2], const Unit& u, int wr, int wc, int fr, int fq) const {
        const int row0 = u.pm * BM + wr * 64 + fr, col0 = u.pn * BM + wc * 32 + 4 * fq;
#pragma unroll
        for (int ai = 0; ai < 2; ++ai)
#pragma unroll
            for (int m = 0; m < 4; ++m) { float* rowp = C + (size_t)(row0 + ai * HALF + m * 16) * ldc + col0;
#pragma unroll
                for (int bj = 0; bj < 2; ++bj)
#pragma unroll
                    for (int n = 0; n < 2; ++n) *(f32x4*)(rowp + bj * HALF + n * 16) = acc[ai][bj][m][n]; }
    }
};

constexpr int UPF = 5632, UPF2 = 11264;
template <int CTRL> __device__ __forceinline__ float dpp_mov(float old, float src) {
    return __builtin_bit_cast(float, __builtin_amdgcn_update_dpp(__builtin_bit_cast(int, old), __builtin_bit_cast(int, src), CTRL, 0xF, 0xF, false)); }
struct EpiUpConv {
    static constexpr bool PERMA = true, PERM = true, AFTER_DRAIN = false; static constexpr int MIDK = 0;
    bf16_t* ACT; float* RAWB; const float* cw; const float* cb; PG8_LAS unsigned char* xch;
    __device__ __forceinline__ void mid(f32x4 (&)[2][2][4][2], const Unit&, int, int, int, int) const {}
    __device__ __forceinline__ void operator()(const f32x4 (&acc)[2][2][4][2], const Unit& u, int wr, int wc, int fr, int fq) const {
        const int colh = 32 * wc + 8 * fq; int ca = u.pn * HALF + colh;
        asm volatile("" : "+v"(ca));
        PG8_LAS float* X = (PG8_LAS float*)xch;
        f32x4 w0[2][2], w1[2][2], w2[2][2], bb[2][2];
#pragma unroll
        for (int bj = 0; bj < 2; ++bj)
#pragma unroll
            for (int n = 0; n < 2; ++n) { const float* pc = cw + bj * UPF + ca + 4 * n; w0[bj][n] = *(const f32x4*)pc; w1[bj][n] = *(const f32x4*)(pc + UPF2); w2[bj][n] = *(const f32x4*)(pc + 2 * UPF2);
                bb[bj][n] = *(const f32x4*)(cb + bj * UPF + ca + 4 * n); }
        asm volatile("" ::: "memory");
#pragma unroll
        for (int ai = 0; ai < 2; ++ai) { const int sb = 2 * ai + wr;
            if (fr == 15) {
#pragma unroll
                for (int j = 0; j < 2; ++j)
#pragma unroll
                    for (int bj = 0; bj < 2; ++bj)
#pragma unroll
                        for (int n = 0; n < 2; ++n) {
                            if (sb < 3) *(PG8_LAS f32x4*)(X + ((sb * 2 + j) * 256 + bj * HALF + colh + 4 * n)) = acc[ai][bj][2 + j][n];
                            else *(f32x4*)(RAWB + ((size_t)(u.pm * 4 + 2 + j) * UPF2 + bj * UPF + ca + 4 * n)) = acc[ai][bj][2 + j][n]; } } }
        if (wr == 0 && fr == 0) {
#pragma unroll
            for (int j = 0; j < 2; ++j)
#pragma unroll
                for (int bj = 0; bj < 2; ++bj)
#pragma unroll
                    for (int n = 0; n < 2; ++n) *(f32x4*)(RAWB + ((size_t)(u.pm * 4 + j) * UPF2 + bj * UPF + ca + 4 * n)) = acc[0][bj][j][n]; }
        asm volatile("s_waitcnt lgkmcnt(0)" ::: "memory"); __builtin_amdgcn_s_barrier(); asm volatile("" ::: "memory");
#pragma unroll
        for (int ai = 0; ai < 2; ++ai) {
            const int sp = 2 * ai + wr - 1;
            f32x4 s3[2][2], s2[2][2];
#pragma unroll
            for (int bj = 0; bj < 2; ++bj)
#pragma unroll
                for (int n = 0; n < 2; ++n) {
                    const f32x4 z = (f32x4){0.f, 0.f, 0.f, 0.f};
                    const f32x4 pv2 = (sp >= 0) ? *(const PG8_LAS f32x4*)(X + ((sp * 2 + 0) * 256 + bj * HALF + colh + 4 * n)) : z;
                    const f32x4 pv3 = (sp >= 0) ? *(const PG8_LAS f32x4*)(X + ((sp * 2 + 1) * 256 + bj * HALF + colh + 4 * n)) : z;
#pragma unroll
                    for (int j = 0; j < 4; ++j) { s3[bj][n][j] = dpp_mov<0x111>(pv3[j], acc[ai][bj][3][n][j]); s2[bj][n][j] = dpp_mov<0x111>(pv2[j], acc[ai][bj][2][n][j]); } }
#pragma unroll
            for (int m = 0; m < 4; ++m) {
                f32x4 cv[2][2];
#pragma unroll
                for (int bj = 0; bj < 2; ++bj)
#pragma unroll
                    for (int n = 0; n < 2; ++n) { const f32x4 v = acc[ai][bj][m][n];
                        const f32x4 p1 = (m == 0) ? s3[bj][n] : acc[ai][bj][m > 0 ? m - 1 : 0][n];
                        const f32x4 p2 = (m == 0) ? s2[bj][n] : (m == 1) ? s3[bj][n] : acc[ai][bj][m > 1 ? m - 2 : 0][n];
                        cv[bj][n] = bb[bj][n] + w0[bj][n] * p2 + w1[bj][n] * p1 + w2[bj][n] * v; }
                const f32x4 o0 = gelu_v4(cv[0][0]) * cv[1][0], o1 = gelu_v4(cv[0][1]) * cv[1][1];
                u32x4 w; w.x = cvt_pk_bf16(o0[0], o0[1]); w.y = cvt_pk_bf16(o0[2], o0[3]); w.z = cvt_pk_bf16(o1[0], o1[1]); w.w = cvt_pk_bf16(o1[2], o1[3]);
                const int row = u.pm * BM + ai * HALF + wr * 64 + 4 * fr + m;
                if (!(ai == 0 && wr == 0 && fr == 0 && m < 2)) *(u32x4*)(ACT + (size_t)row * UPF + ca) = w;
            }
        }
    }
};
struct FixOrder : StaticOrder {
    bf16_t* ACT; const float* RAWB; const float* cw; const float* cb;
    __device__ __forceinline__ void a_ready(const Unit& u) const {
        for (int ch = threadIdx.x; ch < 2 * (UPF / 8); ch += 512) { const int r = ch / (UPF / 8), q8 = (ch % (UPF / 8)) * 8;
            float fct[3]; const float* srcp[3];
#pragma unroll
            for (int k = 0; k < 3; ++k) { const int rr = r - 2 + k;
                const bool has = (rr >= 0 || u.pm > 0); fct[k] = has ? 1.f : 0.f;
                srcp[k] = RAWB + (size_t)(rr >= 0 ? u.pm * 4 + rr : (has ? (u.pm - 1) * 4 + 4 + rr : u.pm * 4)) * UPF2; }
            f32x4 res[4];
#pragma unroll
            for (int hh = 0; hh < 2; ++hh) {
                f32x4 bz[2], wv[3][2], sv[3][2];
#pragma unroll
                for (int h = 0; h < 2; ++h) bz[h] = *(const f32x4*)(cb + hh * UPF + q8 + 4 * h);
#pragma unroll
                for (int k = 0; k < 3; ++k)
#pragma unroll
                    for (int h = 0; h < 2; ++h) { wv[k][h] = *(const f32x4*)(cw + k * UPF2 + hh * UPF + q8 + 4 * h); sv[k][h] = *(const f32x4*)(srcp[k] + hh * UPF + q8 + 4 * h); }
                asm volatile("" ::: "memory"); __builtin_amdgcn_sched_barrier(0);
#pragma unroll
                for (int h = 0; h < 2; ++h) { f32x4 t = bz[h];
#pragma unroll
                    for (int k = 0; k < 3; ++k) t += (wv[k][h] * fct[k]) * sv[k][h];
                    res[2 * hh + h] = t; }
                __builtin_amdgcn_sched_barrier(0); }
            const f32x4 a0 = res[0], a1 = res[1], g0 = res[2], g1 = res[3];
            u32x4 w; w.x = cvt_pk_bf16(gelu_tanh_f(a0[0]) * g0[0], gelu_tanh_f(a0[1]) * g0[1]); w.y = cvt_pk_bf16(gelu_tanh_f(a0[2]) * g0[2], gelu_tanh_f(a0[3]) * g0[3]);
            w.z = cvt_pk_bf16(gelu_tanh_f(a1[0]) * g1[0], gelu_tanh_f(a1[1]) * g1[1]); w.w = cvt_pk_bf16(gelu_tanh_f(a1[2]) * g1[2], gelu_tanh_f(a1[3]) * g1[3]);
            *(u32x4*)(ACT + (size_t)(u.pm * BM + r) * UPF + q8) = w; }
        asm volatile("s_waitcnt vmcnt(0)" ::: "memory"); __builtin_amdgcn_s_barrier(); asm volatile("" ::: "memory");
    }
};

struct PanelSS {
    unsigned* xbuf;
    unsigned* cnt;
    unsigned* tmo;
    float eps;
    __device__ __forceinline__ void run(const f32x4 (&v)[2][2][4][2], const Unit& u, int wr, int wc, int fr, int fq, PG8_LAS unsigned char* lds, int wid, int lane) const {
        PG8_LAS float* P = (PG8_LAS float*)lds;
        PG8_LAS float* S = (PG8_LAS float*)(lds + 8192);
#pragma unroll
        for (int ai = 0; ai < 2; ++ai)
#pragma unroll
            for (int m = 0; m < 4; ++m) { float q = 0.f;
#pragma unroll
                for (int bj = 0; bj < 2; ++bj)
#pragma unroll
                    for (int n = 0; n < 2; ++n) { const f32x4 x = v[ai][bj][m][n]; q += (x[0] * x[0] + x[1] * x[1]) + (x[2] * x[2] + x[3] * x[3]); }
                q += __shfl_xor(q, 16); q += __shfl_xor(q, 32);
                if (fq == 0) P[(ai * HALF + wr * 64 + m * 16 + fr) * 4 + wc] = q; }
        asm volatile("s_waitcnt lgkmcnt(0)" ::: "memory"); __builtin_amdgcn_s_barrier(); asm volatile("" ::: "memory");
        const int row = wid * 32 + (lane & 31);
        if (lane < 32) { const float q = (P[row * 4 + 0] + P[row * 4 + 1]) + (P[row * 4 + 2] + P[row * 4 + 3]);
            __hip_atomic_store(xbuf + ((size_t)(u.pm * BM + row) * 8 + u.pn), __builtin_bit_cast(unsigned, q), __ATOMIC_RELAXED, __HIP_MEMORY_SCOPE_AGENT); }
        asm volatile("s_waitcnt vmcnt(0)" ::: "memory");
        if (lane == 0) __hip_atomic_fetch_add(cnt + 64 * u.pm, 1u, __ATOMIC_RELAXED, __HIP_MEMORY_SCOPE_AGENT);
        if (wid == 0) {
            unsigned sp = 0;
            while ((unsigned)__builtin_amdgcn_readfirstlane(__hip_atomic_load(cnt + 64 * u.pm, __ATOMIC_RELAXED, __HIP_MEMORY_SCOPE_AGENT)) < 64u) {
                __builtin_amdgcn_s_sleep(2);
                if (++sp > (1u << 20)) { if (lane == 0) __hip_atomic_store(tmo, 1u, __ATOMIC_RELAXED, __HIP_MEMORY_SCOPE_AGENT); break; } }
            asm volatile("" ::: "memory");
        }
        asm volatile("s_waitcnt vmcnt(0) lgkmcnt(0)" ::: "memory"); __builtin_amdgcn_s_barrier(); asm volatile("" ::: "memory");
        if (lane < 32) { const unsigned* slot = xbuf + (size_t)(u.pm * BM + row) * 8; float q = 0.f;
#pragma unroll
            for (int t = 0; t < 8; ++t) q += __builtin_bit_cast(float, __hip_atomic_load(slot + t, __ATOMIC_RELAXED, __HIP_MEMORY_SCOPE_AGENT));
            S[row] = 1.0f / sqrtf(q * (1.0f / 2048.0f) + eps); }
        asm volatile("s_waitcnt lgkmcnt(0)" ::: "memory"); __builtin_amdgcn_s_barrier(); asm volatile("" ::: "memory");
    }
};
struct EpiMixFused {
    static constexpr bool PERMA = false, PERM = true, AFTER_DRAIN = true; static constexpr int MIDK = 0;
    const float* x; bf16_t* X1B; bf16_t* H2; const float* vec; PanelSS st1, st2;
    __device__ __forceinline__ void mid(f32x4 (&)[2][2][4][2], const Unit&, int, int, int, int) const {}
    __device__ __forceinline__ void operator()(const f32x4 (&)[2][2][4][2], const Unit&, int, int, int, int) const {}
    __device__ __forceinline__ void fused(f32x4 (&acc)[2][2][4][2], const Unit& u, int wr, int wc, int fr, int fq, PG8_LAS unsigned char* lds, int wid, int lane) const {
        const PG8_LAS float* S = (const PG8_LAS float*)(lds + 8192);
        const int col0 = u.pn * BM + wc * 32 + 8 * fq;
        f32x4 g1[2][2];
#pragma unroll
        for (int bj = 0; bj < 2; ++bj)
#pragma unroll
            for (int n = 0; n < 2; ++n) g1[bj][n] = *(const f32x4*)(vec + col0 + bj * HALF + n * 4);
        st1.run(acc, u, wr, wc, fr, fq, lds, wid, lane);
        {
#pragma unroll
          for (int ai = 0; ai < 2; ++ai)
#pragma unroll
            for (int m = 0; m < 4; ++m) { const int r = ai * HALF + wr * 64 + m * 16 + fr; const float rs = S[r]; const size_t off = (size_t)(u.pm * BM + r) * 2048 + col0;
#pragma unroll
                for (int bj = 0; bj < 2; ++bj) { const f32x4 xa = __builtin_nontemporal_load((const f32x4*)(x + off + bj * HALF)), xb = __builtin_nontemporal_load((const f32x4*)(x + off + bj * HALF + 4));
                    const f32x4 x1a = xa + g1[bj][0] * (acc[ai][bj][m][0] * rs), x1b = xb + g1[bj][1] * (acc[ai][bj][m][1] * rs);
                    acc[ai][bj][m][0] = x1a; acc[ai][bj][m][1] = x1b;
                    u32x4 o; o.x = cvt_pk_bf16(x1a[0], x1a[1]); o.y = cvt_pk_bf16(x1a[2], x1a[3]); o.z = cvt_pk_bf16(x1b[0], x1b[1]); o.w = cvt_pk_bf16(x1b[2], x1b[3]);
                    *(u32x4*)(X1B + off + bj * HALF) = o; }
                asm volatile("" ::: "memory"); } }
        f32x4 a2[2][2], b2[2][2];
#pragma unroll
        for (int bj = 0; bj < 2; ++bj)
#pragma unroll
            for (int n = 0; n < 2; ++n) { a2[bj][n] = *(const f32x4*)(vec + 2048 + col0 + bj * HALF + n * 4); b2[bj][n] = *(const f32x4*)(vec + 4096 + col0 + bj * HALF + n * 4); }
        st2.run(acc, u, wr, wc, fr, fq, lds, wid, lane);
        {
#pragma unroll
          for (int ai = 0; ai < 2; ++ai)
#pragma unroll
            for (int m = 0; m < 4; ++m) { const int r = ai * HALF + wr * 64 + m * 16 + fr; const float rs = S[r]; const size_t off = (size_t)(u.pm * BM + r) * 2048 + col0;
#pragma unroll
                for (int bj = 0; bj < 2; ++bj) { const f32x4 ha = acc[ai][bj][m][0] * rs * a2[bj][0] + b2[bj][0], hb = acc[ai][bj][m][1] * rs * a2[bj][1] + b2[bj][1];
                    u32x4 o; o.x = cvt_pk_bf16(ha[0], ha[1]); o.y = cvt_pk_bf16(ha[2], ha[3]); o.z = cvt_pk_bf16(hb[0], hb[1]); o.w = cvt_pk_bf16(hb[2], hb[3]);
                    *(u32x4*)(H2 + off + bj * HALF) = o; } } }
    }
};
struct EpiOutFused {
    static constexpr bool PERMA = false, PERM = true, AFTER_DRAIN = true; static constexpr int MIDK = 0;
    const bf16_t* X1B; float* out; const float* vec; PanelSS st;
    __device__ __forceinline__ void mid(f32x4 (&)[2][2][4][2], const Unit&, int, int, int, int) const {}
    __device__ __forceinline__ void operator()(const f32x4 (&)[2][2][4][2], const Unit&, int, int, int, int) const {}
    __device__ __forceinline__ void fused(f32x4 (&acc)[2][2][4][2], const Unit& u, int wr, int wc, int fr, int fq, PG8_LAS unsigned char* lds, int wid, int lane) const {
        const PG8_LAS float* S = (const PG8_LAS float*)(lds + 8192);
        const int col0 = u.pn * BM + wc * 32 + 8 * fq;
        f32x4 g2[2][2];
#pragma unroll
        for (int bj = 0; bj < 2; ++bj)
#pragma unroll
            for (int n = 0; n < 2; ++n) g2[bj][n] = *(const f32x4*)(vec + 3 * 2048 + col0 + bj * HALF + n * 4);
        st.run(acc, u, wr, wc, fr, fq, lds, wid, lane);
#pragma unroll
        for (int ai = 0; ai < 2; ++ai)
#pragma unroll
            for (int m = 0; m < 4; ++m) { const int r = ai * HALF + wr * 64 + m * 16 + fr; const float rs = S[r]; const size_t off = (size_t)(u.pm * BM + r) * 2048 + col0;
#pragma unroll
                for (int bj = 0; bj < 2; ++bj) { const u32x4 xb = __builtin_nontemporal_load((const u32x4*)(X1B + off + bj * HALF));
                    const f32x4 xa = (f32x4){bf_lo(xb.x), bf_hi(xb.x), bf_lo(xb.y), bf_hi(xb.y)}, xc = (f32x4){bf_lo(xb.z), bf_hi(xb.z), bf_lo(xb.w), bf_hi(xb.w)};
                    __builtin_nontemporal_store(xa + g2[bj][0] * (acc[ai][bj][m][0] * rs), (f32x4*)(out + off + bj * HALF)); __builtin_nontemporal_store(xc + g2[bj][1] * (acc[ai][bj][m][1] * rs), (f32x4*)(out + off + bj * HALF + 4)); }
                asm volatile("" ::: "memory"); }
    }
};

template <class Epi, class Sched, bool ALIGN_EPI = false, bool SP2 = false, int EPI_S = 0>
__device__ __forceinline__ void gemm_phase(PG8_LAS unsigned char* lds, const Gemm g, const Sched& S, const Epi& E) {
    const int tid = threadIdx.x, wid = __builtin_amdgcn_readfirstlane(tid >> 6), lane = tid & 63, wr = wid >> 2, wc = wid & 3, fr = lane & 15, fq = lane >> 4;
    const int K = g.K, nt = K / BK;
    unsigned voffA[2], voffB[2];
#pragma unroll
    for (int i = 0; i < 2; ++i) { int R, C; stage_rc(tid * 16 + i * 8192, R, C); const int Rb = Epi::PERM ? ((R & ~31) + perm32(R & 31)) : R;
        const int Ra = Epi::PERMA ? ((R & ~63) + 4 * (R & 15) + ((R >> 4) & 3)) : R;
        voffA[i] = (unsigned)(Ra * K + C) * 2u; voffB[i] = (unsigned)(Rb * K + C) * 2u; }
    const size_t kstep = (size_t)(BK * 2);
    const size_t hstep = (size_t)HALF * K * 2;
    const size_t tstep = 2 * hstep;
    const size_t hstepB = g.b_hstep ? g.b_hstep : hstep, tstepB = g.b_tstep ? g.b_tstep : tstep;
    const unsigned ldsw = (unsigned)wid * 1024u;
    const int aoff = lds_byte(wr * 64 + fr, fq * 8), boff = lds_byte(wc * 32 + fr, fq * 8);
#define PG8_SA(b, h) (((b) * 2 + (h)) * HTB)
#define PG8_SB(b, h) ((4 + (b) * 2 + (h)) * HTB)
#define PG8_STAGE(bufoff, gbase, voff) do { _Pragma("unroll") for (int _i = 0; _i < 2; ++_i) \
        __builtin_amdgcn_raw_ptr_buffer_load_lds((&(voff)[0] == &voffA[0]) ? rsA : rsB, (PG8_LAS void*)(lds + (bufoff) + ldsw + _i * 8192), 16, (int)(voff)[_i], (int)(gbase), 0, 0); } while (0)
#define PG8_LDA(dst, b, h) do { _Pragma("unroll") for (int m = 0; m < 4; ++m) _Pragma("unroll") for (int k = 0; k < 2; ++k) dst[m][k] = *(const PG8_LAS bf16x8*)(lds + PG8_SA(b, h) + aoff + m * 2048 + k * 1024); } while (0)
#define PG8_PIECE(bufoff, gbase, voff, i) __builtin_amdgcn_raw_ptr_buffer_load_lds((&(voff)[0] == &voffA[0]) ? rsA : rsB, (PG8_LAS void*)(lds + (bufoff) + ldsw + (i) * 8192), 16, (int)(voff)[i], (int)(gbase), 0, 0)
#define PG8_LDAM(dst, b, h, m) do { _Pragma("unroll") for (int k = 0; k < 2; ++k) dst[m][k] = *(const PG8_LAS bf16x8*)(lds + PG8_SA(b, h) + aoff + (m) * 2048 + k * 1024); } while (0)
#define PG8_LDA_STAGE2(dst, b, h, off0, g0, v0, off1, g1, v1) do { PG8_LDAM(dst, b, h, 0); PG8_PIECE(off0, g0, v0, 0); PG8_LDAM(dst, b, h, 1); PG8_PIECE(off0, g0, v0, 1); PG8_LDAM(dst, b, h, 2); PG8_PIECE(off1, g1, v1, 0); PG8_LDAM(dst, b, h, 3); PG8_PIECE(off1, g1, v1, 1); } while (0)
#define PG8_LDB(dst, b, h) do { _Pragma("unroll") for (int n = 0; n < 2; ++n) _Pragma("unroll") for (int k = 0; k < 2; ++k) dst[n][k] = *(const PG8_LAS bf16x8*)(lds + PG8_SB(b, h) + boff + n * 2048 + k * 1024); } while (0)
#define PG8_MMA(ai, bj, At, Bt) do { __builtin_amdgcn_s_setprio(1); _Pragma("unroll") for (int m = 0; m < 4; ++m) _Pragma("unroll") for (int n = 0; n < 2; ++n) _Pragma("unroll") for (int k = 0; k < 2; ++k) \
        acc[ai][bj][m][n] = __builtin_amdgcn_mfma_f32_16x16x32_bf16(Bt[n][k], At[m][k], acc[ai][bj][m][n], 0, 0, 0); __builtin_amdgcn_s_setprio(0); } while (0)
#define PG8_WAIT_V(n) asm volatile("s_waitcnt vmcnt(" #n ")" ::: "memory")
#define PG8_WAIT_VN(n) asm volatile("s_waitcnt vmcnt(%0)" :: "i"(n) : "memory")
#define PG8_WAIT_L(n) asm volatile("s_waitcnt lgkmcnt(" #n ")" ::: "memory")
#define PG8_BAR __builtin_amdgcn_s_barrier()
#define PG8_SCHED __builtin_amdgcn_sched_barrier(0)
    Unit cur, nxt; int ui = 0;
    [[maybe_unused]] bool fa = false;
    if (!S.next(0, cur)) return;
    f32x4 acc[2][2][4][2];
#pragma unroll
    for (int a = 0; a < 2; ++a)
#pragma unroll
        for (int b = 0; b < 2; ++b)
#pragma unroll
            for (int m = 0; m < 4; ++m)
#pragma unroll
                for (int n = 0; n < 2; ++n) acc[a][b][m][n] = (f32x4){0.f, 0.f, 0.f, 0.f};
    bf16x8 At[4][2], B0[2][2], B1[2][2];
    const __amdgpu_buffer_rsrc_t rsA = __builtin_amdgcn_make_buffer_rsrc((void*)g.A, 0, (int)((size_t)g.M * K * 2), 0x00020000), rsB = __builtin_amdgcn_make_buffer_rsrc((void*)g.Bt, 0, (int)((size_t)g.N * K * 2), 0x00020000);
    unsigned cA = (unsigned)((size_t)cur.pm * tstep), cB = (unsigned)((size_t)cur.pn * tstepB);
    S.a_ready(cur);
    if constexpr (SP2) {
        PG8_STAGE(PG8_SB(0, 0), cB, voffB); PG8_STAGE(PG8_SB(0, 1), cB + hstepB, voffB); PG8_STAGE(PG8_SA(0, 0), cA, voffA); PG8_STAGE(PG8_SA(0, 1), cA + hstep, voffA);
        if (wr == 1) PG8_BAR;
        PG8_WAIT_V(2); PG8_BAR;
        PG8_STAGE(PG8_SB(1, 0), cB + kstep, voffB); PG8_STAGE(PG8_SB(1, 1), cB + hstepB + kstep, voffB);
        PG8_WAIT_V(6); PG8_BAR;
    } else {
        PG8_STAGE(PG8_SB(0, 0), cB, voffB); PG8_STAGE(PG8_SA(0, 0), cA, voffA); PG8_STAGE(PG8_SB(0, 1), cB + hstepB, voffB); PG8_STAGE(PG8_SA(0, 1), cA + hstep, voffA);
        if (wr == 1) PG8_BAR;
        PG8_WAIT_V(4); PG8_BAR;
        PG8_STAGE(PG8_SB(1, 0), cB + kstep, voffB); PG8_STAGE(PG8_SA(1, 0), cA + kstep, voffA); PG8_STAGE(PG8_SB(1, 1), cB + hstepB + kstep, voffB);
        PG8_WAIT_V(6); PG8_BAR;
    }
    for (;;) {
        const bool has_next = S.next(ui + 1, nxt);
        const unsigned nA = has_next ? (unsigned)((size_t)nxt.pm * tstep) : cA, nB = has_next ? (unsigned)((size_t)nxt.pn * tstepB) : cB;
        for (int tb = 0; tb < nt; ) {
        const int te = (Epi::MIDK > 0 && tb < Epi::MIDK) ? Epi::MIDK : nt;
        if constexpr (Epi::MIDK > 0) { if (tb == Epi::MIDK) E.mid(acc, cur, wr, wc, fr, fq); }
#define PG8_KBODY(V1, V2, V3, DO_A1) { \
            const bool last = (t == nt - 2); \
            const unsigned a1 = cA + (unsigned)((t + 1) * kstep); \
            const unsigned a2 = last ? nA : cA + (unsigned)((t + 2) * kstep), b2 = last ? nB : cB + (unsigned)((t + 2) * kstep); \
            const unsigned b3 = b2 + (unsigned)kstep; \
            if (last && has_next) S.a_ready(nxt); \
              \
            PG8_LDB(B0, 0, 0); PG8_LDB(B1, 0, 1); PG8_SCHED; if (DO_A1) { PG8_LDA_STAGE2(At, 0, 0, PG8_SA(1, 0), a1, voffA, PG8_SA(1, 1), a1 + hstep, voffA); } else { PG8_LDA(At, 0, 0); } \
            PG8_WAIT_VN(V1); PG8_WAIT_L(0); PG8_BAR; PG8_MMA(0, 0, At, B0); PG8_MMA(0, 1, At, B1); PG8_BAR; PG8_SCHED; \
              \
            PG8_LDA_STAGE2(At, 0, 1, PG8_SB(0, 0), b2, voffB, PG8_SB(0, 1), b2 + hstepB, voffB); \
            PG8_WAIT_VN(V2); PG8_WAIT_L(0); PG8_BAR; PG8_MMA(1, 0, At, B0); PG8_MMA(1, 1, At, B1); PG8_BAR; PG8_SCHED; \
              \
            PG8_LDB(B0, 1, 0); PG8_LDB(B1, 1, 1); PG8_SCHED; PG8_LDA_STAGE2(At, 1, 0, PG8_SA(0, 0), a2, voffA, PG8_SA(0, 1), a2 + hstep, voffA); \
            PG8_WAIT_VN(V3); PG8_WAIT_L(0); PG8_BAR; PG8_MMA(0, 0, At, B0); PG8_MMA(0, 1, At, B1); PG8_BAR; PG8_SCHED; \
              \
            PG8_LDA_STAGE2(At, 1, 1, PG8_SB(1, 0), b3, voffB, PG8_SB(1, 1), b3 + hstepB, voffB); \
            PG8_WAIT_VN(6); PG8_WAIT_L(0); PG8_BAR; PG8_MMA(1, 0, At, B0); PG8_MMA(1, 1, At, B1); PG8_BAR; PG8_SCHED; }
        static_assert(SP2, "this body keeps only the two-super-phase K-loop");
        int t = tb;
        if constexpr (EPI_S > 0) { if (fa && t == 0 && te >= 2) { PG8_KBODY(8 + EPI_S, 6 + EPI_S, 8 + EPI_S, false); t = 2; } }
        for (; t < te; t += 2) PG8_KBODY(8, 6, 8, true);
        tb = te; }
        if constexpr (ALIGN_EPI) { if (wr == 0) PG8_BAR; }
        if constexpr (EPI_S > 0 && ALIGN_EPI) { fa = has_next; if (has_next) { PG8_STAGE(PG8_SA(1, 0), nA + kstep, voffA); PG8_STAGE(PG8_SA(1, 1), nA + kstep + hstep, voffA); PG8_WAIT_VN(4); } }
        if constexpr (!Epi::AFTER_DRAIN) { E(acc, cur, wr, wc, fr, fq); S.done(cur); }
        if (!has_next) break;
#pragma unroll
        for (int a = 0; a < 2; ++a)
#pragma unroll
            for (int b = 0; b < 2; ++b)
#pragma unroll
                for (int m = 0; m < 4; ++m)
#pragma unroll
                    for (int n = 0; n < 2; ++n) acc[a][b][m][n] = (f32x4){0.f, 0.f, 0.f, 0.f};
        cur = nxt; cA = nA; cB = nB; ++ui;
        if constexpr (ALIGN_EPI) { if (wr == 1) PG8_BAR; }
    }
    PG8_WAIT_V(0);
    if constexpr (!ALIGN_EPI) { if (wr == 0) PG8_BAR; }
    PG8_BAR;
    if constexpr (Epi::AFTER_DRAIN) { E.fused(acc, cur, wr, wc, fr, fq, lds, wid, lane); S.done(cur); }
#undef PG8_SA
#undef PG8_SB
#undef PG8_STAGE
#undef PG8_LDA
#undef PG8_PIECE
#undef PG8_LDAM
#undef PG8_LDA_STAGE2
#undef PG8_LDB
#undef PG8_MMA
#undef PG8_WAIT_VN
#undef PG8_KBODY
#undef PG8_WAIT_V
#undef PG8_WAIT_L
#undef PG8_BAR
#undef PG8_SCHED
}
}
#define GAS __attribute__((address_space(1)))
#define LAS __attribute__((address_space(3)))
typedef unsigned short bf16;
typedef unsigned v4u __attribute__((ext_vector_type(4)));
typedef float f32x4 __attribute__((ext_vector_type(4)));
typedef short bf16x8 __attribute__((ext_vector_type(8)));
typedef GAS unsigned gu32;
typedef GAS unsigned long long gu64;
#define RLX_AGENT __ATOMIC_RELAXED, __HIP_MEMORY_SCOPE_AGENT
#define LDS_WAIT() asm volatile("s_waitcnt lgkmcnt(0)" ::: "memory")
#define VM_WAIT() asm volatile("s_waitcnt vmcnt(0)" ::: "memory")
__device__ __forceinline__ unsigned long long rt() { return __builtin_amdgcn_s_memrealtime(); }
__device__ __forceinline__ unsigned f2bf(float f) { unsigned u = __builtin_bit_cast(unsigned, f); return (u + 0x7fffu + ((u >> 16) & 1u)) >> 16; }
__device__ __forceinline__ unsigned pk2(float lo, float hi) { return f2bf(lo) | (f2bf(hi) << 16); }

#define XB_TMO      128
#define XB_XCNT(j)  (256  + 64 * (j))
#define XB_XSUB(j)  (1280 + 64 * (j))
#define XB_XGEN(j)  (2304 + 64 * (j))
#define XB_TOP      3328
#define XB_TOPGEN   3392
#define XCD_BAR_WORDS 3456
#define XB_SPIN_CAP (1u << 18)

__device__ __forceinline__ unsigned xb_ld(unsigned* p)              { return __hip_atomic_load(p, __ATOMIC_RELAXED, __HIP_MEMORY_SCOPE_AGENT); }
__device__ __forceinline__ unsigned xb_add(unsigned* p, unsigned v) { return __hip_atomic_fetch_add(p, v, __ATOMIC_RELAXED, __HIP_MEMORY_SCOPE_AGENT); }
__device__ __forceinline__ unsigned xb_xcc_id() { return (unsigned)__builtin_amdgcn_s_getreg((3 << 11) | 20) & 0xFu; }
#define XB_SPIN(cond, bar) do { unsigned _sp = 0; while (cond) { __builtin_amdgcn_s_sleep(1); \
    if ((++_sp & 255u) == 0u) { if (xb_ld(&(bar)[XB_TMO])) break; if (_sp > XB_SPIN_CAP) { atomicAdd(&(bar)[XB_TMO], 1u); break; } } } } while (0)

struct XcdBarrier {
    unsigned* bar; unsigned x;
    volatile LAS unsigned* st;
};

__device__ __forceinline__ XcdBarrier xcd_barrier_post(unsigned* bar, volatile LAS unsigned* st) {
    XcdBarrier b; b.bar = bar; b.x = xb_xcc_id(); b.st = st;
    if (threadIdx.x == 0) (void)xb_add(&bar[XB_XCNT(b.x)], 1u);
    return b;
}
__device__ __forceinline__ void xcd_barrier_complete(unsigned* bar, unsigned x, unsigned& nloc, unsigned& nx) {
    const unsigned G = gridDim.x * gridDim.y * gridDim.z;
    unsigned sum, cnt, mine, sp = 0u;
    for (;;) {
        sum = 0u; cnt = 0u; mine = 0u;
#pragma unroll
        for (unsigned j = 0; j < 16; ++j) { const unsigned c = xb_ld(&bar[XB_XCNT(j)]); sum += c; cnt += (c > 0u) ? 1u : 0u; mine = (j == x) ? c : mine; }
        if (sum == G) break;
        __builtin_amdgcn_s_sleep(1);
        if ((++sp & 255u) == 0u) { if (xb_ld(&bar[XB_TMO])) break; if (sp > XB_SPIN_CAP) { atomicAdd(&bar[XB_TMO], 1u); break; } }
    }
    nloc = mine > 0u ? mine : 1u; nx = cnt > 0u ? cnt : 1u;
}

__device__ __forceinline__ void xcd_barrier(const XcdBarrier& b) {
    asm volatile("s_waitcnt vmcnt(0)" ::: "memory");
    __syncthreads();
    if (threadIdx.x == 0) {
        unsigned* bar = b.bar;
        __builtin_amdgcn_s_waitcnt(0);
        unsigned nloc = b.st[0], nx = b.st[1];
        if (nloc == 0u) { xcd_barrier_complete(bar, b.x, nloc, nx); b.st[0] = nloc; b.st[1] = nx; }
        const unsigned old = xb_add(&bar[XB_XSUB(b.x)], 1u);
        const unsigned gen = old / nloc;
        if (old + 1u == (gen + 1u) * nloc) {
            __builtin_amdgcn_fence(__ATOMIC_RELEASE, "agent");
            asm volatile("s_waitcnt vmcnt(0)" ::: "memory");
            const unsigned og = xb_add(&bar[XB_TOP], 1u);
            const unsigned tg = og / nx;
            const bool last_xcd = (og + 1u == (tg + 1u) * nx);
            if (last_xcd) xb_add(&bar[XB_TOPGEN], 1u);
            asm volatile("buffer_inv sc1" ::: "memory");
            if (!last_xcd) XB_SPIN(xb_ld(&bar[XB_TOPGEN]) == tg, bar);
            asm volatile("" ::: "memory");
            xb_add(&bar[XB_XGEN(b.x)], 1u);
            asm volatile("s_waitcnt vmcnt(0)" ::: "memory");
        } else {
            asm volatile("buffer_inv sc1" ::: "memory");
            XB_SPIN(xb_ld(&bar[XB_XGEN(b.x)]) == gen, bar);
            asm volatile("s_waitcnt vmcnt(0)" ::: "memory");
        }
    }
    __syncthreads();
}

#ifndef MK_N_LAUNCHES
#define MK_N_LAUNCHES 1
#endif
constexpr int NWAVES = 8, NPHASES = 10;
constexpr int N_LAUNCHES = MK_N_LAUNCHES;
constexpr int SEQ = 8192, DM = 2048, AW = 2048, BW = 1024, INC = 9216, FF = 5632, FF2 = 11264, NMOD = 12288, KAB = 3072;
constexpr float EPS = 1e-6f;
constexpr size_t MiB = 1u << 20;
constexpr size_t WS_CTL = 0, CTL_ZERO_BYTES = 256 * 1024;
constexpr size_t WS_MOD = 64 * 1024, WS_STATS = 128 * 1024;
constexpr size_t WS_CNT = 192 * 1024;
constexpr size_t WS_XBUF = 1 * MiB + 128 * 1024;
constexpr size_t WS_VEC = 1 * MiB;
constexpr size_t WS_WIN = 2 * MiB, WS_WAB = 38 * MiB, WS_WOUT = 50 * MiB, WS_WUP = 58 * MiB, WS_WDN = 102 * MiB, WS_WPOOL = 124 * MiB, WS_WSP = WS_WPOOL + 512 * 1024;
constexpr size_t WS_H1 = 125 * MiB, WS_U = 157 * MiB, WS_V = 189 * MiB, WS_P = 221 * MiB, WS_GA = 237 * MiB, WS_GB = 269 * MiB;
constexpr size_t WS_SGPB = 301 * MiB, WS_MERGED = 349 * MiB, WS_MIX = 125 * MiB, WS_H2 = 301 * MiB, WS_ACT = 125 * MiB, WS_Y = 213 * MiB;
constexpr size_t WS_RAWB = 389 * MiB;
constexpr size_t WS_END = 395 * MiB;
constexpr int CW_BAR = 4096;
static_assert((CW_BAR + XCD_BAR_WORDS) * 4 <= (int)WS_MOD && WS_MOD + NMOD * 4 <= WS_STATS && WS_STATS + SEQ * 8 <= WS_CNT && WS_CNT + 3 * 32 * 256 <= CTL_ZERO_BYTES && WS_XBUF + 3 * 256 * 1024 <= 2 * MiB, "CTL map");
constexpr int RING_OFF = 0, RING_BYTES = 131072, LDSCTL_OFF = RING_BYTES, MISC_OFF = LDSCTL_OFF + 320, XCH_OFF = RING_BYTES + 1024, LDS_BYTES = 147456;

typedef unsigned v2u __attribute__((ext_vector_type(2)));
__device__ __forceinline__ float wave_sum(float v) {
#pragma unroll
    for (int o = 1; o < 64; o <<= 1) v += __shfl_xor(v, o);
    return v;
}
__device__ __forceinline__ float sigm(float z) { return __builtin_amdgcn_rcpf(1.0f + __builtin_amdgcn_exp2f(z * -1.44269504089f)); }
__device__ __forceinline__ float gelu_t(float x) { const float z = x * (1.5957691216f + 0.0713548163f * x * x); return x * sigm(z); }
__device__ __forceinline__ float bflo(unsigned w) { return __builtin_bit_cast(float, w << 16); }
__device__ __forceinline__ float bfhi(unsigned w) { return __builtin_bit_cast(float, w & 0xffff0000u); }

__device__ __forceinline__ void p0_mod_gemv(const float* c, const float* w_ada, const float* b_ada, float* MOD, LAS unsigned char* lds, int vcu, int G, int tid, int lane, int wave) {
    constexpr int NCG = NMOD / 256, NKR = DM / 128;
    LAS float* red = (LAS float*)lds;
    for (int it = vcu; it < NCG * NKR; it += G) {
        const int cg = it % NCG, kr = it / NCG, k0 = kr * 128 + wave * 16, col = cg * 256 + lane * 4;
        float cv = c[k0 + (lane & 15)]; cv = cv * sigm(cv);
        f32x4 a = (f32x4){0.f, 0.f, 0.f, 0.f};
#pragma unroll
        for (int kk = 0; kk < 16; ++kk) { const float s = __shfl(cv, kk); const f32x4 w = __builtin_nontemporal_load((const f32x4*)(w_ada + (size_t)(k0 + kk) * NMOD + col)); a += w * s; }
        *(LAS f32x4*)(red + wave * 256 + lane * 4) = a;
        __syncthreads();
        if (tid < 256) { float s = 0.f;
#pragma unroll
            for (int w = 0; w < 8; ++w) s += red[w * 256 + tid];
            if (kr == 0) s += b_ada[cg * 256 + tid];
            atomicAdd(MOD + cg * 256 + tid, s); }
        __syncthreads();
    }
}
struct TrDesc { const float* W; bf16* WT; int N, dpitch, koff, item; };
__device__ __forceinline__ void tr_load(const TrDesc& d, int lane, float (&tmp)[32]) {
    const int nblk = d.N / 32, kb = d.item / nblk, nb = d.item % nblk, k0 = 64 * kb, n0 = 32 * nb;
    const float* src = d.W + (size_t)(k0 + (lane >> 5)) * d.N + n0 + (lane & 31);
#pragma unroll
    for (int i = 0; i < 32; ++i) tmp[i] = __builtin_nontemporal_load(src + (size_t)(2 * i) * d.N);
}
__device__ __forceinline__ void tr_store(const TrDesc& d, const float (&tmp)[32], LAS float* scr, int lane) {
    const int nblk = d.N / 32, kb = d.item / nblk, nb = d.item % nblk, k0 = 64 * kb, n0 = 32 * nb;
#pragma unroll
    for (int i = 0; i < 32; ++i) scr[(2 * i + (lane >> 5)) * 33 + (lane & 31)] = tmp[i];
    LDS_WAIT(); asm volatile("" ::: "memory");
    const int c = lane & 7;
#pragma unroll
    for (int j = 0; j < 4; ++j) { const int n = (lane >> 3) + 8 * j; const LAS float* s = scr + (8 * c) * 33 + n;
        v4u o; o.x = pg8::cvt_pk_bf16(s[0 * 33], s[1 * 33]); o.y = pg8::cvt_pk_bf16(s[2 * 33], s[3 * 33]); o.z = pg8::cvt_pk_bf16(s[4 * 33], s[5 * 33]); o.w = pg8::cvt_pk_bf16(s[6 * 33], s[7 * 33]);
        *(v4u*)(d.WT + (size_t)(n0 + n) * d.dpitch + d.koff + k0 + 8 * c) = o; }
    LDS_WAIT(); asm volatile("" ::: "memory");
}
template <class L> __device__ __forceinline__ void convert_list(const L& list, int n, int start, int stride, LAS float* scr, int lane) {
    float ta[32], tb[32]; TrDesc da, db; int it = start;
    if (it < n) { da = list.get(it); tr_load(da, lane, ta); }
    while (it < n) {
        int it2 = it + stride; if (it2 < n) { db = list.get(it2); tr_load(db, lane, tb); }
        tr_store(da, ta, scr, lane);
        it = it2; if (it >= n) break;
        it2 = it + stride; if (it2 < n) { da = list.get(it2); tr_load(da, lane, ta); }
        tr_store(db, tb, scr, lane);
        it = it2;
    }
}
struct ListOne { const float* W; bf16* WT; int N, dpitch, koff, first; __device__ __forceinline__ TrDesc get(int r) const { return TrDesc{W, WT, N, dpitch, koff, first + r}; } };
struct ListP0 {
    const float *win, *wpool; bf16 *Win_t, *WpT;
    static constexpr int I_IN = (DM / 64) * (INC / 32), I_P = (256 / 64) * (256 / 32), NITEMS = I_IN + 4 * I_P;
    __device__ __forceinline__ TrDesc get(int r) const {
        if (r < I_IN) return TrDesc{win, Win_t, INC, DM, 0, r}; r -= I_IN;
        const int gi = r / I_P; return TrDesc{wpool + (size_t)gi * 65536, WpT + (size_t)gi * 65536, 256, 256, 0, r % I_P};
    }
};
struct ListP2 {
    const float *wa, *wb, *wout, *wup; bf16 *Wab_t, *Wout_t, *Wup_t;
    static constexpr int I_A = (AW / 64) * (DM / 32), I_B = (BW / 64) * (DM / 32), I_O = (DM / 64) * (DM / 32), I_U = (DM / 64) * (FF2 / 32), NITEMS = I_A + I_B + I_O + I_U;
    __device__ __forceinline__ TrDesc get(int r) const {
        if (r < I_A) return TrDesc{wa, Wab_t, DM, KAB, 0, r}; r -= I_A;
        if (r < I_B) return TrDesc{wb, Wab_t, DM, KAB, AW, r}; r -= I_B;
        if (r < I_O) return TrDesc{wout, Wout_t, DM, DM, 0, r}; r -= I_O;
        return TrDesc{wup, Wup_t, FF2, DM, 0, r};
    }
};

typedef short v4s __attribute__((ext_vector_type(4)));
__device__ __forceinline__ void p3_spatial(LAS unsigned char* lds, int n, int h, const bf16* V, const bf16* U, const float* stats, const float* ln_g, const float* ln_b,
                                           const bf16* Wsp, const float* b_sp, bf16* SGPB, int tid, int lane, int wave) {
    LAS float* MR = (LAS float*)lds;
    LAS bf16* IM = (LAS bf16*)(lds + 2048);
    const int t0 = n * 128, d0 = h * 256;
    asm volatile("" : "+v"(tid), "+v"(lane));
    const int fr = lane & 15, fq = lane >> 4;
    float st_s = 0.f, st_q = 0.f;
    if (tid < 128) { st_s = stats[2 * (t0 + tid)]; st_q = stats[2 * (t0 + tid) + 1]; }
    const int c8 = (tid & 31) * 8, j0 = tid >> 5;
    v4u rawv[8];
#pragma unroll
    for (int it = 0; it < 8; ++it) rawv[it] = __builtin_nontemporal_load((const v4u*)(V + (size_t)(t0 + j0 + 16 * it) * AW + d0 + c8));
    const f32x4 g0 = *(const f32x4*)(ln_g + d0 + c8), g1 = *(const f32x4*)(ln_g + d0 + c8 + 4), b0 = *(const f32x4*)(ln_b + d0 + c8), b1 = *(const f32x4*)(ln_b + d0 + c8 + 4);
    const bf16* wbase = Wsp + (size_t)h * 16384;
    bf16x8 wf[4][8];
#pragma unroll
    for (int ks = 0; ks < 4; ++ks)
#pragma unroll
        for (int ib = 0; ib < 8; ++ib) if (32 * ks <= 16 * ib + 15) wf[ks][ib] = *(const bf16x8*)(wbase + (16 * ib + fr) * 128 + 32 * ks + 8 * fq);
    float bsv[8];
#pragma unroll
    for (int ib = 0; ib < 8; ++ib) bsv[ib] = b_sp[h * 128 + 16 * ib + fr];
    asm volatile("" ::: "memory");
    if (tid < 128) { const float mu = st_s * (1.0f / AW), var = fmaxf(st_q * (1.0f / AW) - mu * mu, 0.f), rstd = 1.0f / sqrtf(var + EPS);
        MR[2 * tid] = rstd; MR[2 * tid + 1] = -mu * rstd; }
    __syncthreads();
#pragma unroll
    for (int it = 0; it < 8; ++it) { const int j = j0 + 16 * it; const float rs = MR[2 * j], cc = MR[2 * j + 1]; const v4u raw = rawv[it];
        const f32x4 va = (f32x4){bflo(raw.x), bfhi(raw.x), bflo(raw.y), bfhi(raw.y)}, vb = (f32x4){bflo(raw.z), bfhi(raw.z), bflo(raw.w), bfhi(raw.w)};
        const f32x4 oa = (va * rs + cc) * g0 + b0, ob = (vb * rs + cc) * g1 + b1;
        v4u pk; pk.x = pg8::cvt_pk_bf16(oa[0], oa[1]); pk.y = pg8::cvt_pk_bf16(oa[2], oa[3]); pk.z = pg8::cvt_pk_bf16(ob[0], ob[1]); pk.w = pg8::cvt_pk_bf16(ob[2], ob[3]);
        *(LAS v4u*)(IM + j * 264 + c8) = pk; }
    __syncthreads();
    f32x4 acc[2][8];
#pragma unroll
    for (int a = 0; a < 2; ++a)
#pragma unroll
        for (int b = 0; b < 8; ++b) acc[a][b] = (f32x4){0.f, 0.f, 0.f, 0.f};
    const LAS bf16* trb = IM + (8 * fq + (fr >> 2)) * 264 + 32 * wave + 4 * (fr & 3);
#pragma unroll
    for (int ks = 0; ks < 4; ++ks) {
        bf16x8 a[2];
#pragma unroll
        for (int dbi = 0; dbi < 2; ++dbi) {
            const v4s lo = __builtin_amdgcn_ds_read_tr16_b64_v4i16((LAS v4s*)(trb + (32 * ks) * 264 + 16 * dbi));
            const v4s hi = __builtin_amdgcn_ds_read_tr16_b64_v4i16((LAS v4s*)(trb + (32 * ks + 4) * 264 + 16 * dbi));
            a[dbi] = (bf16x8){lo[0], lo[1], lo[2], lo[3], hi[0], hi[1], hi[2], hi[3]}; }
#pragma unroll
        for (int ib = 0; ib < 8; ++ib) {
            if (32 * ks <= 16 * ib + 15) {
                const bf16x8 b = wf[ks][ib];
#pragma unroll
                for (int dbi = 0; dbi < 2; ++dbi) acc[dbi][ib] = __builtin_amdgcn_mfma_f32_16x16x32_bf16(a[dbi], b, acc[dbi][ib], 0, 0, 0);
            }
        }
    }
    v4u uu[8];
#pragma unroll
    for (int it = 0; it < 8; ++it) { const int idx = tid + 512 * it; uu[it] = __builtin_nontemporal_load((const v4u*)(U + (size_t)(t0 + (idx >> 5)) * AW + d0 + (idx & 31) * 8)); }
    __syncthreads();
    LAS bf16* OUT = IM;
#pragma unroll
    for (int ib = 0; ib < 8; ++ib) { const int i = 16 * ib + fr; const float bs = bsv[ib];
#pragma unroll
        for (int dbi = 0; dbi < 2; ++dbi) { const f32x4 m = acc[dbi][ib] + bs;
            v2u o; o.x = pg8::cvt_pk_bf16(m[0], m[1]); o.y = pg8::cvt_pk_bf16(m[2], m[3]);
            *(LAS v2u*)(OUT + i * 264 + 16 * (2 * wave + dbi) + 4 * fq) = o; } }
    __syncthreads();
#pragma unroll
    for (int it = 0; it < 8; ++it) { const int idx = tid + 512 * it, i = idx >> 5, cc8 = (idx & 31) * 8;
        const v4u mx = *(const LAS v4u*)(OUT + i * 264 + cc8); const v4u ux = uu[it];
        v4u o; o.x = pg8::cvt_pk_bf16(bflo(ux.x) * bflo(mx.x), bfhi(ux.x) * bfhi(mx.x)); o.y = pg8::cvt_pk_bf16(bflo(ux.y) * bflo(mx.y), bfhi(ux.y) * bfhi(mx.y));
        o.z = pg8::cvt_pk_bf16(bflo(ux.z) * bflo(mx.z), bfhi(ux.z) * bfhi(mx.z)); o.w = pg8::cvt_pk_bf16(bflo(ux.w) * bflo(mx.w), bfhi(ux.w) * bfhi(mx.w));
        *(v4u*)(SGPB + (size_t)(t0 + i) * KAB + d0 + cc8) = o; }
}
template <int GI>
__device__ __forceinline__ void p3_pool(LAS unsigned char* lds, int r, const bf16* P, const bf16* WpT, const float* pscale, bf16* SGPB, int tid, int lane, int wave) {
    LAS bf16* Ap = (LAS bf16*)lds;
    constexpr int gi = GI, win = 2 << GI, NW = win - 1;
    const int t0 = r * 128;
    asm volatile("" : "+v"(tid), "+v"(lane));
    const int fr = lane & 15, fq = lane >> 4;
    const bf16* wbase = WpT + (size_t)gi * 65536;
    bf16x8 af[8][2];
#pragma unroll
    for (int ks = 0; ks < 8; ++ks)
#pragma unroll
        for (int ebi = 0; ebi < 2; ++ebi) af[ks][ebi] = *(const bf16x8*)(wbase + (16 * (2 * wave + ebi) + fr) * 256 + 32 * ks + 8 * fq);
    {
        const int q8 = (tid & 31) * 8, tl0 = (tid >> 5) * 8; const bf16* pc = P + gi * 256 + q8;
        v4u rw[NW + 8];
#pragma unroll
        for (int i = 0; i < NW + 8; ++i) { const int ts = t0 + tl0 - NW + i; rw[i] = *(const v4u*)(pc + (size_t)(ts >= 0 ? ts : 0) * BW); }
        float sum[8] = {0.f, 0.f, 0.f, 0.f, 0.f, 0.f, 0.f, 0.f};
#pragma unroll
        for (int sI = 1; sI <= NW; ++sI) { const int ts = t0 + tl0 - sI; const float fct = (ts >= 0) ? 1.f : 0.f; const v4u raw = rw[NW - sI];
            sum[0] += fct * bflo(raw.x); sum[1] += fct * bfhi(raw.x); sum[2] += fct * bflo(raw.y); sum[3] += fct * bfhi(raw.y); sum[4] += fct * bflo(raw.z); sum[5] += fct * bfhi(raw.z); sum[6] += fct * bflo(raw.w); sum[7] += fct * bfhi(raw.w); }
#pragma unroll
        for (int k = 0; k < 8; ++k) { const int t = t0 + tl0 + k; const v4u raw = rw[NW + k];
            const float self[8] = {bflo(raw.x), bfhi(raw.x), bflo(raw.y), bfhi(raw.y), bflo(raw.z), bfhi(raw.z), bflo(raw.w), bfhi(raw.w)};
#pragma unroll
            for (int e = 0; e < 8; ++e) sum[e] += self[e];
            const int cnt = (t + 1 < win) ? (t + 1) : win; const float inv = 1.0f / (float)cnt;
            v4u o; o.x = pg8::cvt_pk_bf16(sum[0] * inv - self[0], sum[1] * inv - self[1]); o.y = pg8::cvt_pk_bf16(sum[2] * inv - self[2], sum[3] * inv - self[3]);
            o.z = pg8::cvt_pk_bf16(sum[4] * inv - self[4], sum[5] * inv - self[5]); o.w = pg8::cvt_pk_bf16(sum[6] * inv - self[6], sum[7] * inv - self[7]);
            *(LAS v4u*)(Ap + (tl0 + k) * 264 + q8) = o;
            const int td = t - win + 1;
            { const float fct = (td >= 0) ? 1.f : 0.f; const v4u rd = rw[k];
                sum[0] -= fct * bflo(rd.x); sum[1] -= fct * bfhi(rd.x); sum[2] -= fct * bflo(rd.y); sum[3] -= fct * bfhi(rd.y); sum[4] -= fct * bflo(rd.z); sum[5] -= fct * bfhi(rd.z); sum[6] -= fct * bflo(rd.w); sum[7] -= fct * bfhi(rd.w); } }
    }
    __syncthreads();
    f32x4 acc[2][8];
#pragma unroll
    for (int a = 0; a < 2; ++a)
#pragma unroll
        for (int b = 0; b < 8; ++b) acc[a][b] = (f32x4){0.f, 0.f, 0.f, 0.f};
#pragma unroll
    for (int ks = 0; ks < 8; ++ks) {
        bf16x8 a[2];
#pragma unroll
        for (int ebi = 0; ebi < 2; ++ebi) a[ebi] = af[ks][ebi];
#pragma unroll
        for (int tb = 0; tb < 8; ++tb) { const bf16x8 b = *(const LAS bf16x8*)(Ap + (16 * tb + fr) * 264 + 32 * ks + 8 * fq);
#pragma unroll
            for (int ebi = 0; ebi < 2; ++ebi) acc[ebi][tb] = __builtin_amdgcn_mfma_f32_16x16x32_bf16(a[ebi], b, acc[ebi][tb], 0, 0, 0); }
    }
    __syncthreads();
#pragma unroll
    for (int ebi = 0; ebi < 2; ++ebi) { const int e = 16 * (2 * wave + ebi) + 4 * fq; const f32x4 sc = *(const f32x4*)(pscale + gi * 256 + e);
#pragma unroll
        for (int tb = 0; tb < 8; ++tb) { const f32x4 m = acc[ebi][tb] * sc;
            v2u o; o.x = pg8::cvt_pk_bf16(m[0], m[1]); o.y = pg8::cvt_pk_bf16(m[2], m[3]);
            *(LAS v2u*)(Ap + (16 * tb + fr) * 264 + e) = o; } }
    __syncthreads();
#pragma unroll
    for (int it = 0; it < 8; ++it) { const int idx = tid + 512 * it, t = idx >> 5, c8 = (idx & 31) * 8;
        *(v4u*)(SGPB + (size_t)(t0 + t) * KAB + AW + gi * 256 + c8) = *(const LAS v4u*)(Ap + t * 264 + c8); }
}

struct Params { const float* in[22]; float* out; unsigned char* ws; int ph_lo, ph_hi; };
enum { I_X = 0, I_C, I_WADA, I_BADA, I_GPREMIX, I_GPOSTMIX, I_WIN, I_LNG, I_LNB, I_WSP, I_BSP, I_WPOOL, I_PSCALE, I_WA, I_WB, I_WOUT, I_GPREFFN, I_GPOSTFFN, I_WUP, I_CONVW, I_CONVB, I_WDN };

__global__ void __launch_bounds__(NWAVES * 64, 2) fwd_megakernel(Params p) {
    extern __shared__ __attribute__((aligned(16))) unsigned char lds_raw[];
    LAS unsigned char* lds = (LAS unsigned char*)lds_raw;
    volatile LAS unsigned* MISC = (volatile LAS unsigned*)(lds + MISC_OFF);
    const int tid = threadIdx.x, lane = tid & 63, wave = __builtin_amdgcn_readfirstlane(tid >> 6);
    const int G = gridDim.x, bx = blockIdx.x, vcu = (G % 8 == 0) ? (bx % 8) * (G / 8) + bx / 8 : bx;
    const int gw = vcu * NWAVES + wave, NGW = G * NWAVES;
    unsigned char* ws = p.ws;
    for (int u = tid; u < (LDS_BYTES - LDSCTL_OFF) / 4; u += NWAVES * 64) ((LAS unsigned*)(lds + LDSCTL_OFF))[u] = 0u;
    __syncthreads();
    const int lo = p.ph_lo, hi = p.ph_hi;
    XcdBarrier bar; bar.bar = (unsigned*)(ws + WS_CTL) + CW_BAR; bar.x = 0; bar.st = nullptr;
    if (hi - lo > 1) bar = xcd_barrier_post((unsigned*)(ws + WS_CTL) + CW_BAR, MISC + 8);
#define IN(k) (lo <= (k) && (k) < hi)
#define SEAM(k) do { if (IN(k) && IN((k) + 1)) xcd_barrier(bar); } while (0)

    float* MOD = (float*)(ws + WS_MOD); float* STATS = (float*)(ws + WS_STATS); float* VEC = (float*)(ws + WS_VEC);
    bf16 *Win_t = (bf16*)(ws + WS_WIN), *Wab_t = (bf16*)(ws + WS_WAB), *Wout_t = (bf16*)(ws + WS_WOUT), *Wup_t = (bf16*)(ws + WS_WUP), *Wdn_t = (bf16*)(ws + WS_WDN), *WpT = (bf16*)(ws + WS_WPOOL), *Wsp = (bf16*)(ws + WS_WSP);
    bf16 *H1 = (bf16*)(ws + WS_H1), *Ub = (bf16*)(ws + WS_U), *Vb = (bf16*)(ws + WS_V), *Pb = (bf16*)(ws + WS_P), *GA = (bf16*)(ws + WS_GA), *GB = (bf16*)(ws + WS_GB);
    bf16 *SGPB = (bf16*)(ws + WS_SGPB), *MERGED = (bf16*)(ws + WS_MERGED), *ACT = (bf16*)(ws + WS_ACT), *H2 = (bf16*)(ws + WS_H2);
    float *MIX = (float*)(ws + WS_MIX), *Y = (float*)(ws + WS_Y), *RAWB = (float*)(ws + WS_RAWB);
    const float* x = p.in[I_X]; float* out = p.out;

    unsigned* const gcnt = (unsigned*)(ws + WS_CTL) + 16;
    const bool split = false;
    const bool gemv_role = !split || (((bx >> 3) & 1) == 0);
    const int n_gemv = split ? G / 2 : G, i_gemv = split ? (bx >> 4) * 8 + (bx & 7) : vcu, n_conv = split ? G / 2 : G, i_conv = split ? (bx >> 4) * 8 + (bx & 7) : vcu;
    if (IN(0)) {
        if (gemv_role) {
            p0_mod_gemv(p.in[I_C], p.in[I_WADA], p.in[I_BADA], MOD, lds + RING_OFF, i_gemv, n_gemv, tid, lane, wave);
            VM_WAIT(); __syncthreads();
            if (tid == 0) __hip_atomic_fetch_add(gcnt, 1u, RLX_AGENT);
        }
        if (!split || !gemv_role) { LAS float* scr = (LAS float*)(lds + RING_OFF + wave * 16384);
            const ListP0 L{p.in[I_WIN], p.in[I_WPOOL], Win_t, WpT}; convert_list(L, ListP0::NITEMS, i_conv * NWAVES + wave, n_conv * NWAVES, scr, lane); }
        for (int idx = gw * 64 + lane; idx < 8 * 128 * 128; idx += NGW * 64) { const int i = (idx >> 7) & 127, j = idx & 127; Wsp[idx] = (bf16)((j <= i) ? f2bf(p.in[I_WSP][idx]) : 0u); }
    }
    if (IN(0) && IN(1)) {
        if (wave == 0) { unsigned sp = 0;
            while ((unsigned)__builtin_amdgcn_readfirstlane(__hip_atomic_load(gcnt, RLX_AGENT)) < (unsigned)n_gemv) { __builtin_amdgcn_s_sleep(2); if (++sp > (1u << 20)) break; }
            __builtin_amdgcn_fence(__ATOMIC_ACQUIRE, "agent"); VM_WAIT(); }
        __syncthreads();
    }
    if (IN(1)) {
        if (bx == 0) for (int cc = tid; cc < DM; cc += NWAVES * 64) {
            VEC[cc] = MOD[2 * DM + cc] * p.in[I_GPOSTMIX][cc];
            VEC[DM + cc] = p.in[I_GPREFFN][cc] * (1.0f + MOD[4 * DM + cc]);
            VEC[2 * DM + cc] = MOD[3 * DM + cc];
            VEC[3 * DM + cc] = MOD[5 * DM + cc] * p.in[I_GPOSTFFN][cc]; }
        f32x4 ca[8], cb[8];
#pragma unroll
        for (int j = 0; j < 8; ++j) { const int cc = 8 * lane + 512 * (j >> 1) + 4 * (j & 1); const f32x4 g = *(const f32x4*)(p.in[I_GPREMIX] + cc), sc = *(const f32x4*)(MOD + DM + cc); ca[j] = g * (sc + 1.0f); cb[j] = *(const f32x4*)(MOD + cc); }
        {   int m = gw; f32x4 v[8], nx[8];
            if (m < SEQ) { const f32x4* xr = (const f32x4*)(x + (size_t)m * DM) + 2 * lane;
#pragma unroll
                for (int j = 0; j < 8; ++j) v[j] = __builtin_nontemporal_load(xr + 128 * (j >> 1) + (j & 1)); }
            for (; m < SEQ; m += NGW) {
                const int mn = (m + NGW < SEQ) ? m + NGW : m;
                { const f32x4* xr = (const f32x4*)(x + (size_t)mn * DM) + 2 * lane;
#pragma unroll
                  for (int j = 0; j < 8; ++j) nx[j] = __builtin_nontemporal_load(xr + 128 * (j >> 1) + (j & 1)); }
                asm volatile("" ::: "memory");
                float ss = 0.f;
#pragma unroll
                for (int j = 0; j < 8; ++j) ss += (v[j][0] * v[j][0] + v[j][1] * v[j][1]) + (v[j][2] * v[j][2] + v[j][3] * v[j][3]);
                const float rstd = 1.0f / sqrtf(wave_sum(ss) * (1.0f / DM) + EPS);
                v4u* o16 = (v4u*)(H1 + (size_t)m * DM) + lane;
#pragma unroll
                for (int jq = 0; jq < 4; ++jq) { const f32x4 ha = v[2 * jq] * rstd * ca[2 * jq] + cb[2 * jq], hb = v[2 * jq + 1] * rstd * ca[2 * jq + 1] + cb[2 * jq + 1];
                    v4u o; o.x = pg8::cvt_pk_bf16(ha[0], ha[1]); o.y = pg8::cvt_pk_bf16(ha[2], ha[3]); o.z = pg8::cvt_pk_bf16(hb[0], hb[1]); o.w = pg8::cvt_pk_bf16(hb[2], hb[3]); o16[64 * jq] = o; }
#pragma unroll
                for (int j = 0; j < 8; ++j) v[j] = nx[j];
            }
        }
    }
    SEAM(1);
    if (IN(2)) {
        pg8::Gemm g{H1, Win_t, SEQ, INC, DM}; pg8::StaticOrder S; S.init(SEQ, INC, G, bx);
        pg8::EpiIn E{Ub, Vb, Pb, GA, GB, STATS};
        pg8::gemm_phase<pg8::EpiIn, pg8::StaticOrder, true, true, 16>(lds + RING_OFF, g, S, E);
        {
            const int rem = (32 * 36) % G, nidle = rem ? G - rem : G, idle = rem ? bx - rem : bx;
            if (idle >= 0) { LAS float* scr = (LAS float*)(lds + RING_OFF + wave * 16384);
                const ListP2 L{p.in[I_WA], p.in[I_WB], p.in[I_WOUT], p.in[I_WUP], Wab_t, Wout_t, Wup_t}; convert_list(L, ListP2::NITEMS, idle * NWAVES + wave, nidle * NWAVES, scr, lane); }
        }
    }
    SEAM(2);
    if (IN(3)) {
        for (int u = vcu; u < 768; u += G) {
            __syncthreads();
            if (u < 512) p3_spatial(lds + RING_OFF, u >> 3, u & 7, Vb, Ub, STATS, p.in[I_LNG], p.in[I_LNB], Wsp, p.in[I_BSP], SGPB, tid, lane, wave);
            else { const int rp = (u - 512) >> 2;
                switch ((u - 512) & 3) {
                    case 0: p3_pool<0>(lds + RING_OFF, rp, Pb, WpT, p.in[I_PSCALE], SGPB, tid, lane, wave); break;
                    case 1: p3_pool<1>(lds + RING_OFF, rp, Pb, WpT, p.in[I_PSCALE], SGPB, tid, lane, wave); break;
                    case 2: p3_pool<2>(lds + RING_OFF, rp, Pb, WpT, p.in[I_PSCALE], SGPB, tid, lane, wave); break;
                    default: p3_pool<3>(lds + RING_OFF, rp, Pb, WpT, p.in[I_PSCALE], SGPB, tid, lane, wave); break; } }
        }
        __syncthreads();
    }
    SEAM(3);
    if (IN(4)) {
        pg8::Gemm g{SGPB, Wab_t, SEQ, DM, KAB}; pg8::StaticOrder S; S.init(SEQ, DM, G, bx);
        pg8::EpiMerge E{GA, GB, MERGED};
        pg8::gemm_phase<pg8::EpiMerge, pg8::StaticOrder, true, true>(lds + RING_OFF, g, S, E);
    }
    SEAM(4);
    const bool fuse = (G == 256);
    unsigned* const xb = (unsigned*)(ws + WS_XBUF); unsigned* const pc = (unsigned*)(ws + WS_CNT); unsigned* const tmo = (unsigned*)(ws + WS_CTL) + 2;
    if (IN(5)) {
        pg8::Gemm g{MERGED, Wout_t, SEQ, DM, DM}; pg8::StaticOrder S; S.init(SEQ, DM, G, bx);
        if (fuse) {
            pg8::EpiMixFused E{x, (bf16*)(ws + WS_Y), H2, VEC, pg8::PanelSS{xb, pc, tmo, EPS}, pg8::PanelSS{xb + 65536, pc + 2048, tmo, EPS}};
            pg8::gemm_phase<pg8::EpiMixFused, pg8::StaticOrder, false, true>(lds + RING_OFF, g, S, E);
        } else {
            pg8::EpiF32 E{MIX, DM};
            pg8::gemm_phase<pg8::EpiF32, pg8::StaticOrder, true, true>(lds + RING_OFF, g, S, E);
        }
    }
    if (!fuse) SEAM(5);
    if (IN(6) && !fuse) {
        {   int m = gw; f32x4 v[8], w[8], nv[8], nw[8];
            if (m < SEQ) { const f32x4* xr = (const f32x4*)(x + (size_t)m * DM) + lane; const f32x4* mr = (const f32x4*)(MIX + (size_t)m * DM) + lane;
#pragma unroll
                for (int j = 0; j < 8; ++j) { v[j] = xr[64 * j]; w[j] = mr[64 * j]; } }
            for (; m < SEQ; m += NGW) {
                const int mn = (m + NGW < SEQ) ? m + NGW : m;
                { const f32x4* xr = (const f32x4*)(x + (size_t)mn * DM) + lane; const f32x4* mr = (const f32x4*)(MIX + (size_t)mn * DM) + lane;
#pragma unroll
                  for (int j = 0; j < 8; ++j) { nv[j] = xr[64 * j]; nw[j] = mr[64 * j]; } }
                asm volatile("" ::: "memory");
                float ss = 0.f;
#pragma unroll
                for (int j = 0; j < 8; ++j) ss += (w[j][0] * w[j][0] + w[j][1] * w[j][1]) + (w[j][2] * w[j][2] + w[j][3] * w[j][3]);
                const float rstd = 1.0f / sqrtf(wave_sum(ss) * (1.0f / DM) + EPS); float s1 = 0.f;
                f32x4* o4 = (f32x4*)(out + (size_t)m * DM) + lane;
#pragma unroll
                for (int j = 0; j < 8; ++j) { const f32x4 g1 = *((const f32x4*)VEC + lane + 64 * j); v[j] = v[j] + g1 * (w[j] * rstd); o4[64 * j] = v[j];
                    s1 += (v[j][0] * v[j][0] + v[j][1] * v[j][1]) + (v[j][2] * v[j][2] + v[j][3] * v[j][3]); }
                const float rstd1 = 1.0f / sqrtf(wave_sum(s1) * (1.0f / DM) + EPS);
                uint2* o8 = (uint2*)(H2 + (size_t)m * DM) + lane;
#pragma unroll
                for (int j = 0; j < 8; ++j) { const f32x4 a2 = *((const f32x4*)(VEC + DM) + lane + 64 * j), b2 = *((const f32x4*)(VEC + 2 * DM) + lane + 64 * j);
                    const f32x4 h = v[j] * rstd1 * a2 + b2; uint2 o; o.x = pk2(h[0], h[1]); o.y = pk2(h[2], h[3]); o8[64 * j] = o; }
#pragma unroll
                for (int j = 0; j < 8; ++j) { v[j] = nv[j]; w[j] = nw[j]; }
            }
        }
    }
    SEAM(6);
    if (IN(7)) {
        pg8::Gemm g{H2, Wup_t, SEQ, FF2, DM, (size_t)FF * DM * 2, (size_t)128 * DM * 2}; pg8::StaticOrder S; S.init(SEQ, FF2, G, bx);
        pg8::EpiUpConv E{ACT, RAWB, p.in[I_CONVW], p.in[I_CONVB], lds + XCH_OFF};
        pg8::gemm_phase<pg8::EpiUpConv, pg8::StaticOrder, true, true, 0>(lds + RING_OFF, g, S, E);
        {
            const int rem = (32 * 44) % G, nidle = rem ? G - rem : G, idle = rem ? bx - rem : bx;
            if (idle >= 0) { LAS float* scr = (LAS float*)(lds + RING_OFF + wave * 16384);
                const ListOne L{p.in[I_WDN], Wdn_t, DM, FF, 0, 0}; convert_list(L, (FF / 64) * (DM / 32), idle * NWAVES + wave, nidle * NWAVES, scr, lane); }
        }
    }
    SEAM(7);
    if (IN(8)) {
        pg8::Gemm g{ACT, Wdn_t, SEQ, DM, FF}; pg8::FixOrder S; S.init(SEQ, DM, G, bx); S.ACT = ACT; S.RAWB = RAWB; S.cw = p.in[I_CONVW]; S.cb = p.in[I_CONVB];
        if (fuse) {
            pg8::EpiOutFused E{(const bf16*)(ws + WS_Y), out, VEC, pg8::PanelSS{xb + 2 * 65536, pc + 2 * 2048, tmo, EPS}};
            pg8::gemm_phase<pg8::EpiOutFused, pg8::FixOrder, false, true>(lds + RING_OFF, g, S, E);
        } else {
            pg8::EpiF32 E{Y, DM};
            pg8::gemm_phase<pg8::EpiF32, pg8::FixOrder, true, true>(lds + RING_OFF, g, S, E);
        }
    }
    if (!fuse) SEAM(8);
    if (IN(9) && !fuse) {
        {   int m = gw; f32x4 v[8], w[8], nv[8], nw[8];
            if (m < SEQ) { const f32x4* xr = (const f32x4*)(out + (size_t)m * DM) + lane; const f32x4* yr = (const f32x4*)(Y + (size_t)m * DM) + lane;
#pragma unroll
                for (int j = 0; j < 8; ++j) { v[j] = xr[64 * j]; w[j] = yr[64 * j]; } }
            for (; m < SEQ; m += NGW) {
                const bool has = (m + NGW < SEQ); const int mn = has ? m + NGW : m;
                if (has) { const f32x4* xr = (const f32x4*)(out + (size_t)mn * DM) + lane; const f32x4* yr = (const f32x4*)(Y + (size_t)mn * DM) + lane;
#pragma unroll
                  for (int j = 0; j < 8; ++j) { nv[j] = xr[64 * j]; nw[j] = yr[64 * j]; } }
                asm volatile("" ::: "memory");
                float ss = 0.f;
#pragma unroll
                for (int j = 0; j < 8; ++j) ss += (w[j][0] * w[j][0] + w[j][1] * w[j][1]) + (w[j][2] * w[j][2] + w[j][3] * w[j][3]);
                const float rstd = 1.0f / sqrtf(wave_sum(ss) * (1.0f / DM) + EPS);
                f32x4* o4 = (f32x4*)(out + (size_t)m * DM) + lane;
#pragma unroll
                for (int j = 0; j < 8; ++j) { const f32x4 g2 = *((const f32x4*)(VEC + 3 * DM) + lane + 64 * j); o4[64 * j] = v[j] + g2 * (w[j] * rstd); }
                if (has) {
#pragma unroll
                    for (int j = 0; j < 8; ++j) { v[j] = nv[j]; w[j] = nw[j]; } }
            }
        }
    }
#undef IN
#undef SEAM
}

extern "C" void kernel_launch(void* const* d_in, const int* in_sizes, int n_in, void* d_out, int out_size, void* d_ws, size_t ws_size, hipStream_t stream) {
    static int grid = 0;
    if (grid == 0) {
        if (n_in != 22 || in_sizes[0] != SEQ * DM || out_size != SEQ * DM || ws_size < WS_END) { fprintf(stderr, "kernel_launch: unexpected shapes (n_in %d, in0 %d, out %d, ws %zu < %zu)\n", n_in, n_in > 0 ? in_sizes[0] : -1, out_size, ws_size, (size_t)WS_END); grid = -1; return; }
        int dev = 0, cus = 0, per_cu = 0;
        if (hipGetDevice(&dev) != hipSuccess || hipDeviceGetAttribute(&cus, hipDeviceAttributeMultiprocessorCount, dev) != hipSuccess) { grid = -1; return; }
        if (hipFuncSetAttribute((const void*)fwd_megakernel, hipFuncAttributeMaxDynamicSharedMemorySize, LDS_BYTES) != hipSuccess) { fprintf(stderr, "kernel_launch: hipFuncSetAttribute failed\n"); grid = -1; return; }
        if (hipOccupancyMaxActiveBlocksPerMultiprocessor(&per_cu, (const void*)fwd_megakernel, NWAVES * 64, LDS_BYTES) != hipSuccess || per_cu < 1) { fprintf(stderr, "kernel_launch: occupancy query says %d blocks per CU\n", per_cu); grid = -1; (void)hipGetLastError(); return; }
        grid = cus;
    }
    if (grid < 0) return;
    (void)hipMemsetAsync((char*)d_ws + WS_CTL, 0, CTL_ZERO_BYTES, stream);
    Params a{};
    for (int i = 0; i < 22; ++i) a.in[i] = (const float*)d_in[i];
    a.out = (float*)d_out; a.ws = (unsigned char*)d_ws;
#if defined(PROBE_DUP)
    a.ph_lo = 0; a.ph_hi = PROBE_DUP + 1;
    hipLaunchKernelGGL(fwd_megakernel, dim3(grid), dim3(NWAVES * 64), LDS_BYTES, stream, a);
    (void)hipMemsetAsync((char*)d_ws + WS_CTL, 0, WS_MOD, stream);
    if (PROBE_DUP == 0) (void)hipMemsetAsync((char*)d_ws + WS_MOD, 0, NMOD * 4, stream);
    if (PROBE_DUP <= 2) (void)hipMemsetAsync((char*)d_ws + WS_STATS, 0, SEQ * 8, stream);
    a.ph_lo = PROBE_DUP; a.ph_hi = NPHASES;
    hipLaunchKernelGGL(fwd_megakernel, dim3(grid), dim3(NWAVES * 64), LDS_BYTES, stream, a);
#else
    for (int li = 0; li < N_LAUNCHES; ++li) {
        a.ph_lo = (N_LAUNCHES == 1) ? 0 : li; a.ph_hi = (N_LAUNCHES == 1) ? NPHASES : li + 1;
        hipLaunchKernelGGL(fwd_megakernel, dim3(grid), dim3(NWAVES * 64), LDS_BYTES, stream, a);
    }
#endif
}
```
